# Optimizing an MI355X kernel written in HIP

```python
import math
import jax, jax.numpy as jnp
from jax import lax
import numpy as np

D_MODEL = 1024
BATCH = 8
SEQ = 2048
DEPTH = 4

N_MIXERS = 2
N_A = (DEPTH + 1) // 2
N_B = DEPTH // 2

A_HEADS = 16
A_KV_HEADS = 4
A_GROUP = A_HEADS // A_KV_HEADS
A_HEAD_DIM = 64
A_QKV = A_HEADS * A_HEAD_DIM + 2 * A_KV_HEADS * A_HEAD_DIM
WINDOW = 128
BLK = 128

B_HEADS = 16
Q_LORA = 384
KV_LORA = 256
NOPE_DIM = 64
ROPE_DIM = 32
V_DIM = 64
B_IN = Q_LORA + KV_LORA + ROPE_DIM
ROPE_THETA = 10000.0

D_FF = int(math.ceil(8 * D_MODEL / 3 / 256) * 256)

EPS = 1e-6
NEG = -1e30

kernel_name = "hybrid_swa_sink_alibi_mla_swiglu_encoder"


def _rmsnorm(x, g):
    x32 = x.astype(jnp.float32)
    y = x32 * lax.rsqrt(jnp.mean(x32 * x32, axis=-1, keepdims=True) + EPS)
    return (y * g.astype(jnp.float32)).astype(x.dtype)


def _alibi_slopes(n):
    return jnp.asarray(2.0 ** (-8.0 * np.arange(1, n + 1) / n), dtype=jnp.float32)


def _band(t, nb):
    pad = [(0, 0), (BLK, BLK)] + [(0, 0)] * (t.ndim - 2)
    tp = jnp.pad(t, pad).reshape((t.shape[0], nb + 2, BLK) + t.shape[2:])
    return jnp.concatenate([tp[:, :-2], tp[:, 1:-1], tp[:, 2:]], axis=2)


def _windowed_gqa(h, pos, w_qkv, sink, w_o):
    B, S, _ = h.shape
    nb = S // BLK
    qkv = h @ w_qkv
    q, k, v = jnp.split(qkv, [A_HEADS * A_HEAD_DIM, A_HEADS * A_HEAD_DIM + A_KV_HEADS * A_HEAD_DIM], axis=-1)
    q = q.reshape(B, nb, BLK, A_KV_HEADS, A_GROUP, A_HEAD_DIM) * (A_HEAD_DIM ** -0.5)
    kb = _band(k.reshape(B, S, A_KV_HEADS, A_HEAD_DIM), nb)
    vb = _band(v.reshape(B, S, A_KV_HEADS, A_HEAD_DIM), nb)
    qi = jnp.arange(nb)[:, None] * BLK + jnp.arange(BLK)[None, :]
    ki = (jnp.arange(nb)[:, None] - 1) * BLK + jnp.arange(3 * BLK)[None, :]
    mask = (jnp.abs(qi[:, :, None] - ki[:, None, :]) <= WINDOW) & (ki >= 0)[:, None, :] & (ki < S)[:, None, :]
    qpos = pos.reshape(B, nb, BLK)
    kpos = _band(pos, nb)
    dist = jnp.abs(qpos[:, :, :, None] - kpos[:, :, None, :]).astype(jnp.float32)
    slopes = _alibi_slopes(A_HEADS).reshape(A_KV_HEADS, A_GROUP)
    scores = jnp.einsum('bnqkgd,bnskd->bnkgqs', q, kb).astype(jnp.float32)
    scores = scores - slopes[None, None, :, :, None, None] * dist[:, :, None, None]
    scores = jnp.where(mask[None, :, None, None], scores, NEG)
    sink_col = jnp.broadcast_to(sink.astype(jnp.float32).reshape(1, 1, A_KV_HEADS, A_GROUP, 1, 1),
                                scores.shape[:-1] + (1,))
    p = jax.nn.softmax(jnp.concatenate([scores, sink_col], axis=-1), axis=-1)[..., :-1]
    out = jnp.einsum('bnkgqs,bnskd->bnqkgd', p.astype(vb.dtype), vb)
    return out.reshape(B, S, A_HEADS * A_HEAD_DIM) @ w_o


def _rope(t, pos):
    half = ROPE_DIM // 2
    inv_freq = ROPE_THETA ** (-jnp.arange(half, dtype=jnp.float32) * 2.0 / ROPE_DIM)
    ang = pos.astype(jnp.float32)[:, :, None] * inv_freq[None, None, :]
    cos = jnp.cos(ang)[:, :, None, :]
    sin = jnp.sin(ang)[:, :, None, :]
    t32 = t.astype(jnp.float32)
    t1, t2 = t32[..., :half], t32[..., half:]
    return jnp.concatenate([t1 * cos - t2 * sin, t1 * sin + t2 * cos], axis=-1).astype(t.dtype)


def _mla(h, pos, w_in, g_q, g_kv, w_uq, w_ukv, w_o):
    B, S, _ = h.shape
    nb = S // BLK
    lat = h @ w_in
    cq, ckv, k_rope = jnp.split(lat, [Q_LORA, Q_LORA + KV_LORA], axis=-1)
    cq = _rmsnorm(cq, g_q)
    ckv = _rmsnorm(ckv, g_kv)
    q = (cq @ w_uq).reshape(B, S, B_HEADS, NOPE_DIM + ROPE_DIM)
    kv = (ckv @ w_ukv).reshape(B, S, B_HEADS, NOPE_DIM + V_DIM)
    q_nope, q_rope = q[..., :NOPE_DIM], q[..., NOPE_DIM:]
    k_nope, v = kv[..., :NOPE_DIM], kv[..., NOPE_DIM:]
    q_rope = _rope(q_rope, pos)
    k_rope = _rope(k_rope[:, :, None, :], pos)
    k = jnp.concatenate([k_nope, jnp.broadcast_to(k_rope, (B, S, B_HEADS, ROPE_DIM))], axis=-1)
    q = jnp.concatenate([q_nope, q_rope], axis=-1) * ((NOPE_DIM + ROPE_DIM) ** -0.5)
    qb = q.reshape(B, nb, BLK, B_HEADS, NOPE_DIM + ROPE_DIM).transpose(1, 0, 2, 3, 4)

    def attend(qblk):
        s = jnp.einsum('bqhd,bkhd->bhqk', qblk, k).astype(jnp.float32)
        p = jax.nn.softmax(s, axis=-1)
        return jnp.einsum('bhqk,bkhd->bqhd', p.astype(v.dtype), v)

    o = lax.map(attend, qb)
    o = o.transpose(1, 0, 2, 3, 4).reshape(B, S, B_HEADS * V_DIM)
    return o @ w_o


def _swiglu(h, w_gu, w_down):
    g, u = jnp.split(h @ w_gu, 2, axis=-1)
    return (jax.nn.silu(g) * u) @ w_down


def setup_inputs(seed: int = 0) -> dict:
    key = jax.random.key(seed)
    ks = jax.random.split(key, 20)

    def w(k, shape, fan_in):
        return jax.random.normal(k, shape, jnp.float32) * (fan_in ** -0.5)

    def gain(k, shape):
        return 1.0 + 0.02 * jax.random.normal(k, shape, jnp.float32)

    x = jax.random.normal(ks[0], (BATCH, SEQ, D_MODEL), jnp.float32)
    offset = jax.random.randint(ks[1], (BATCH, 1), 0, 1024, dtype=jnp.int32)
    positions = offset + jnp.arange(SEQ, dtype=jnp.int32)[None, :]
    return {
        "x": x,
        "positions": positions,
        "norm_mix": gain(ks[2], (DEPTH, D_MODEL)),
        "norm_ffn": gain(ks[3], (DEPTH, D_MODEL)),
        "a_w_qkv": w(ks[4], (N_A, D_MODEL, A_QKV), D_MODEL),
        "a_sink": 0.5 * jax.random.normal(ks[5], (N_A, A_HEADS), jnp.float32),
        "a_w_o": w(ks[6], (N_A, A_HEADS * A_HEAD_DIM, D_MODEL), A_HEADS * A_HEAD_DIM),
        "b_w_in": w(ks[7], (N_B, D_MODEL, B_IN), D_MODEL),
        "b_g_q": gain(ks[8], (N_B, Q_LORA)),
        "b_g_kv": gain(ks[9], (N_B, KV_LORA)),
        "b_w_uq": w(ks[10], (N_B, Q_LORA, B_HEADS * (NOPE_DIM + ROPE_DIM)), Q_LORA),
        "b_w_ukv": w(ks[11], (N_B, KV_LORA, B_HEADS * (NOPE_DIM + V_DIM)), KV_LORA),
        "b_w_o": w(ks[12], (N_B, B_HEADS * V_DIM, D_MODEL), B_HEADS * V_DIM),
        "ffn_w_gu": w(ks[13], (DEPTH, D_MODEL, 2 * D_FF), D_MODEL),
        "ffn_w_down": w(ks[14], (DEPTH, D_FF, D_MODEL), D_FF),
        "final_norm": gain(ks[15], (D_MODEL,)),
    }


def reference(x, positions, norm_mix, norm_ffn, a_w_qkv, a_sink, a_w_o, b_w_in, b_g_q, b_g_kv,
              b_w_uq, b_w_ukv, b_w_o, ffn_w_gu, ffn_w_down, final_norm):
    h = x
    for i in range(DEPTH):
        j = i // N_MIXERS
        hn = _rmsnorm(h, norm_mix[i])
        if i % N_MIXERS == 0:
            mix = _windowed_gqa(hn, positions, a_w_qkv[j], a_sink[j], a_w_o[j])
        else:
            mix = _mla(hn, positions, b_w_in[j], b_g_q[j], b_g_kv[j], b_w_uq[j], b_w_ukv[j], b_w_o[j])
        h = h + mix.astype(h.dtype)
        h = h + _swiglu(_rmsnorm(h, norm_ffn[i]), ffn_w_gu[i], ffn_w_down[i]).astype(h.dtype)
    return _rmsnorm(h, final_norm)
```

```cpp
#include <hip/hip_runtime.h>
#include <hip/hip_cooperative_groups.h>
#include <cstdio>
#include <cstdint>
namespace cg = cooperative_groups;

#define LAS __attribute__((address_space(3)))
typedef unsigned short bf16_t;
typedef short bf16x8 __attribute__((ext_vector_type(8)));
typedef short s16x4 __attribute__((ext_vector_type(4)));
typedef float f32x4 __attribute__((ext_vector_type(4)));
typedef float f32x16 __attribute__((ext_vector_type(16)));
typedef unsigned u32x4 __attribute__((ext_vector_type(4)));
typedef unsigned u32x2 __attribute__((ext_vector_type(2)));
typedef int i32x4 __attribute__((ext_vector_type(4)));

constexpr int NB = 8, SEQ = 2048, DM = 1024, T = NB * SEQ;
constexpr int AQKV = 1536, BIN = 672, BINP = 768, QL = 384, KVL = 256, UQ = 1536, UKV = 2048, DFF = 2816, GU = 2 * DFF;
constexpr float EPSN = 1e-6f;
constexpr float LOG2E = 1.4426950408889634f;

constexpr size_t MiB = 1u << 20;
constexpr size_t SZ_WQKV = (size_t)AQKV * DM * 2, SZ_WO = (size_t)DM * DM * 2, SZ_WIN = (size_t)BINP * DM * 2, SZ_WUQ = (size_t)UQ * QL * 2,
                 SZ_WUKV = (size_t)UKV * KVL * 2, SZ_WGU = (size_t)GU * DM * 2, SZ_WDN = (size_t)DM * DFF * 2;
constexpr size_t WS_WQKV = 1 * MiB;
constexpr size_t WS_WOA = WS_WQKV + 2 * SZ_WQKV;
constexpr size_t WS_WIN = WS_WOA + 2 * SZ_WO;
constexpr size_t WS_WUQ = WS_WIN + 2 * SZ_WIN;
constexpr size_t WS_WUKV = WS_WUQ + 2 * SZ_WUQ;
constexpr size_t WS_WOB = WS_WUKV + 2 * SZ_WUKV;
constexpr size_t WS_WGU = WS_WOB + 2 * SZ_WO;
constexpr size_t WS_WDN = WS_WGU + 4 * SZ_WGU;
constexpr size_t WS_WEND = WS_WDN + 4 * SZ_WDN;
constexpr size_t WS_HB = 90 * MiB;
constexpr size_t WS_R0 = 122 * MiB;
constexpr size_t WS_KVM = WS_R0 + 48 * MiB;
constexpr size_t WS_O = WS_KVM + 64 * MiB;
constexpr size_t WS_KR = WS_O + 32 * MiB;
constexpr size_t WS_SSQH = WS_KR + 1 * MiB;
constexpr size_t WS_SSQL = WS_SSQH + 1 * MiB;
constexpr size_t WS_COS = WS_SSQL + 2 * MiB;
constexpr size_t WS_SIN = WS_COS + 1 * MiB;
constexpr size_t WS_POSF = WS_SIN + 1 * MiB;
constexpr size_t WS_LAT = WS_POSF + 1 * MiB;
constexpr size_t WS_END = WS_LAT + 24 * MiB;
static_assert(WS_WEND <= WS_HB, "weights overflow");
static_assert((size_t)T * DFF * 2 <= 112 * MiB, "act overlay");

constexpr int LDS_BYTES = 147456;
#ifndef REP_SYNC
#define REP_SYNC 1
#endif
#ifndef REP_ATT
#define REP_ATT 1
#endif
#ifndef REP_PRO
#define REP_PRO 1
#endif
#define GSYNC() do { for (int _r = 0; _r < REP_SYNC; ++_r) xcd_barrier(xbar, wave_s); } while (0)
#define GSYNC_L() do { if (lmode) xcd_local_barrier(xbar, wave_s); else xcd_barrier(xbar, wave_s); } while (0)

__device__ __forceinline__ int tid_from_wave(int wave_s) { int t = wave_s * 64 + (int)__builtin_amdgcn_mbcnt_hi(~0u, __builtin_amdgcn_mbcnt_lo(~0u, 0u)); asm volatile("" : "+v"(t)); return t; }
typedef float f32x2_t __attribute__((ext_vector_type(2))); typedef __bf16 bf16x2_t __attribute__((ext_vector_type(2)));
__device__ __forceinline__ unsigned cvt_pk_bf16(float lo, float hi) { const f32x2_t v = {lo, hi}; const bf16x2_t b = __builtin_convertvector(v, bf16x2_t); return __builtin_bit_cast(unsigned, b); }
__device__ __forceinline__ float xhalf_max(float m) { auto rr = __builtin_amdgcn_permlane32_swap(__float_as_uint(m), __float_as_uint(m), false, false); return fmaxf(__uint_as_float(rr[0]), __uint_as_float(rr[1])); }
__device__ __forceinline__ float xhalf_sum(float m) { auto rr = __builtin_amdgcn_permlane32_swap(__float_as_uint(m), __float_as_uint(m), false, false); return __uint_as_float(rr[0]) + __uint_as_float(rr[1]); }
template <int K> __device__ __forceinline__ float xor_lane(float v) { return __int_as_float(__builtin_amdgcn_ds_swizzle(__float_as_int(v), (K << 10) | 0x1f)); }
__device__ __forceinline__ float wave_sum(float v) {
    v += xor_lane<1>(v); v += xor_lane<2>(v); v += xor_lane<4>(v); v += xor_lane<8>(v); v += xor_lane<16>(v);
    return xhalf_sum(v);
}

namespace pg8 {
constexpr int BM = 256, BK = 64, HALF = 128, HTB = HALF * BK * 2, STAGE_BYTES = 8 * HTB, NXCD = 8, WGM = 8;
__host__ __device__ __forceinline__ int lds_byte(int r, int c) { const int st = (r >> 4) * 2 + (c >> 5), rr = r & 15, cc = c & 31, ob = rr * 64 + cc * 2; return st * 1024 + (ob ^ (((ob >> 9) & 1) << 5)); }
__host__ __device__ __forceinline__ void stage_rc(int b, int& R, int& C) { const int st = b / 1024, sb = b % 1024, swz = sb ^ (((sb >> 9) & 1) << 5); R = (st >> 1) * 16 + swz / 64; C = (st & 1) * 32 + (swz % 64) / 2; }
__host__ __device__ __forceinline__ int perm32(int rho) { const int n = rho >> 4, i = rho & 15; return 8 * (i >> 2) + 4 * n + (i & 3); }
struct Unit { int pm, pn; };
struct Gemm { const bf16_t* A; const bf16_t* Bt; int M, N, K, lda; };
struct StaticOrder {
    int nM, nN, nwg, G, c;
    __device__ void init(int M, int N, int G_, int c_) { nM = M / BM; nN = N / BM; nwg = nM * nN; G = G_; c = c_; }
    __device__ bool next(int i, Unit& u) const {
        const long L = (long)i * G + c; if (L >= nwg) return false;
        int wgid = (int)L; { const int q = nwg / NXCD, r = nwg % NXCD, xcd = wgid % NXCD, off = wgid / NXCD; wgid = (xcd < r ? xcd * (q + 1) : r * (q + 1) + (xcd - r) * q) + off; }
        const int nig = WGM * nN, gid = wgid / nig, fm = gid * WGM, gsz = (nM - fm) < WGM ? (nM - fm) : WGM;
        u.pm = fm + ((wgid % nig) % gsz); u.pn = (wgid % nig) / gsz; return true;
    }
};

template <class Epi, class Sched, bool ALIGN_EPI>
__device__ __forceinline__ void gemm_phase(LAS unsigned char* lds, const Gemm g, const Sched& S, const Epi& E, const int wave_s) {
    const int tid = tid_from_wave(wave_s);
    const int wid = __builtin_amdgcn_readfirstlane(tid >> 6), lane = tid & 63, wr = wid >> 2, wc = wid & 3, fr = lane & 15, fq = lane >> 4;
    const int K = g.K, nt = K / BK, lda = g.lda;
    unsigned voffA[2], voffB[2];
#pragma unroll
    for (int i = 0; i < 2; ++i) { int R, C; stage_rc(tid * 16 + i * 8192, R, C); const int Rb = Epi::PERM ? ((R & ~31) + perm32(R & 31)) : R;
        voffA[i] = (unsigned)(R * lda + C) * 2u; voffB[i] = (unsigned)(Rb * K + C) * 2u; }
    const size_t kstep = (size_t)(BK * 2);
    const size_t hstepA = (size_t)HALF * lda * 2, hstepB = (size_t)HALF * K * 2;
    const size_t tstepA = 2 * hstepA, tstepB = 2 * hstepB;
    const unsigned ldsw = (unsigned)wid * 1024u;
    const int aoff = lds_byte(wr * 64 + fr, fq * 8), boff = lds_byte(wc * 32 + fr, fq * 8);
#define PG8_SA(b, h) (((b) * 2 + (h)) * HTB)
#define PG8_SB(b, h) ((4 + (b) * 2 + (h)) * HTB)
#define PG8_STAGE(bufoff, gbase, voff) do { _Pragma("unroll") for (int _i = 0; _i < 2; ++_i) \
        __builtin_amdgcn_global_load_lds((const unsigned*)((const char*)(gbase) + (voff)[_i]), (LAS unsigned*)(lds + (bufoff) + ldsw + _i * 8192), 16, 0, 0); } while (0)
#define PG8_LDA(dst, b, h) do { _Pragma("unroll") for (int m = 0; m < 4; ++m) _Pragma("unroll") for (int k = 0; k < 2; ++k) dst[m][k] = *(const LAS bf16x8*)(lds + PG8_SA(b, h) + aoff + m * 2048 + k * 1024); } while (0)
#define PG8_LDB(dst, b, h) do { _Pragma("unroll") for (int n = 0; n < 2; ++n) _Pragma("unroll") for (int k = 0; k < 2; ++k) dst[n][k] = *(const LAS bf16x8*)(lds + PG8_SB(b, h) + boff + n * 2048 + k * 1024); } while (0)
#define PG8_MMA(ai, bj, At, Bt) do { __builtin_amdgcn_s_setprio(1); _Pragma("unroll") for (int m = 0; m < 4; ++m) _Pragma("unroll") for (int n = 0; n < 2; ++n) _Pragma("unroll") for (int k = 0; k < 2; ++k) \
        acc[ai][bj][m][n] = __builtin_amdgcn_mfma_f32_16x16x32_bf16(Bt[n][k], At[m][k], acc[ai][bj][m][n], 0, 0, 0); __builtin_amdgcn_s_setprio(0); } while (0)
#define PG8_WAIT_V(n) asm volatile("s_waitcnt vmcnt(" #n ")" ::: "memory")
#define PG8_WAIT_L(n) asm volatile("s_waitcnt lgkmcnt(" #n ")" ::: "memory")
#define PG8_BAR __builtin_amdgcn_s_barrier()
#define PG8_SCHED __builtin_amdgcn_sched_barrier(0)
    Unit cur, nxt; int ui = 0;
    if (!S.next(0, cur)) return;
    f32x4 acc[2][2][4][2];
    if constexpr (Epi::ACC_INIT) E.init(acc, cur, wr, wc, fr, fq);
    else {
#pragma unroll
    for (int a = 0; a < 2; ++a)
#pragma unroll
        for (int b = 0; b < 2; ++b)
#pragma unroll
            for (int m = 0; m < 4; ++m)
#pragma unroll
                for (int n = 0; n < 2; ++n) acc[a][b][m][n] = (f32x4){0.f, 0.f, 0.f, 0.f};
    }
    bf16x8 At[4][2], B0[2][2], B1[2][2];
    const char* cA = (const char*)g.A + (size_t)cur.pm * tstepA; const char* cB = (const char*)g.Bt + (size_t)cur.pn * tstepB;
    PG8_STAGE(PG8_SB(0, 0), cB, voffB); PG8_STAGE(PG8_SB(0, 1), cB + hstepB, voffB); PG8_STAGE(PG8_SA(0, 0), cA, voffA); PG8_STAGE(PG8_SA(0, 1), cA + hstepA, voffA);
    if (wr == 1) PG8_BAR;
    PG8_WAIT_V(2); PG8_BAR;
    PG8_STAGE(PG8_SB(1, 0), cB + kstep, voffB); PG8_STAGE(PG8_SA(1, 0), cA + kstep, voffA); PG8_STAGE(PG8_SB(1, 1), cB + hstepB + kstep, voffB);
    PG8_WAIT_V(6); PG8_BAR;
    for (;;) {
        const bool has_next = S.next(ui + 1, nxt);
        const char* nA = has_next ? (const char*)g.A + (size_t)nxt.pm * tstepA : cA; const char* nB = has_next ? (const char*)g.Bt + (size_t)nxt.pn * tstepB : cB;
#pragma unroll 1
        for (int t = 0; t < nt; t += 2) {
            const bool last = (t == nt - 2);
            const char* a1 = cA + (size_t)(t + 1) * kstep;
            const char* a2 = last ? nA : cA + (size_t)(t + 2) * kstep; const char* b2 = last ? nB : cB + (size_t)(t + 2) * kstep;
            const char* a3 = a2 + kstep; const char* b3 = b2 + kstep;
            PG8_LDB(B0, 0, 0); PG8_LDB(B1, 0, 1); PG8_SCHED; PG8_LDA(At, 0, 0); PG8_STAGE(PG8_SA(1, 1), a1 + hstepA, voffA);
            PG8_WAIT_V(8); PG8_WAIT_L(0); PG8_BAR; PG8_MMA(0, 0, At, B0); PG8_MMA(0, 1, At, B1); PG8_BAR; PG8_SCHED;
            PG8_LDA(At, 0, 1); PG8_STAGE(PG8_SB(0, 0), b2, voffB); PG8_STAGE(PG8_SB(0, 1), b2 + hstepB, voffB); PG8_STAGE(PG8_SA(0, 0), a2, voffA);
            PG8_WAIT_V(8); PG8_WAIT_L(0); PG8_BAR; PG8_MMA(1, 0, At, B0); PG8_MMA(1, 1, At, B1); PG8_BAR; PG8_SCHED;
            PG8_LDB(B0, 1, 0); PG8_LDB(B1, 1, 1); PG8_SCHED; PG8_LDA(At, 1, 0); PG8_STAGE(PG8_SA(0, 1), a2 + hstepA, voffA);
            PG8_WAIT_V(8); PG8_WAIT_L(0); PG8_BAR; PG8_MMA(0, 0, At, B0); PG8_MMA(0, 1, At, B1); PG8_BAR; PG8_SCHED;
            PG8_LDA(At, 1, 1); PG8_STAGE(PG8_SB(1, 0), b3, voffB); PG8_STAGE(PG8_SB(1, 1), b3 + hstepB, voffB); PG8_STAGE(PG8_SA(1, 0), a3, voffA);
            PG8_WAIT_V(8); PG8_WAIT_L(0); PG8_BAR; PG8_MMA(1, 0, At, B0); PG8_MMA(1, 1, At, B1); PG8_BAR; PG8_SCHED;
        }
        if constexpr (ALIGN_EPI) { if (wr == 0) PG8_BAR; }
        { const int l2 = tid_from_wave(wave_s) & 63; E(acc, cur, wr, wc, l2 & 15, l2 >> 4); }
        if (!has_next) break;
        if constexpr (Epi::ACC_INIT) { const int l3 = tid_from_wave(wave_s) & 63; E.init(acc, nxt, wr, wc, l3 & 15, l3 >> 4); }
        else {
#pragma unroll
        for (int a = 0; a < 2; ++a)
#pragma unroll
            for (int b = 0; b < 2; ++b)
#pragma unroll
                for (int m = 0; m < 4; ++m)
#pragma unroll
                    for (int n = 0; n < 2; ++n) acc[a][b][m][n] = (f32x4){0.f, 0.f, 0.f, 0.f};
        }
        cur = nxt; cA = nA; cB = nB; ++ui;
        if constexpr (ALIGN_EPI) { if (wr == 1) PG8_BAR; }
    }
    PG8_WAIT_V(0);
    if constexpr (!ALIGN_EPI) { if (wr == 0) PG8_BAR; }
    PG8_BAR;
#undef PG8_SA
#undef PG8_SB
#undef PG8_STAGE
#undef PG8_LDA
#undef PG8_LDB
#undef PG8_MMA
#undef PG8_WAIT_V
#undef PG8_WAIT_L
#undef PG8_BAR
#undef PG8_SCHED
}
}

typedef f32x4 AccT[2][2][4][2];
struct RowScale { const float* ssq; int stride, off, n4; float inv_dim; };
__device__ __forceinline__ void load_rstd(float (&rs)[2][4], const RowScale& R, int row0, int fq) {
#pragma unroll
    for (int ai = 0; ai < 2; ++ai)
#pragma unroll
        for (int m = 0; m < 4; ++m) {
            const int row = row0 + ai * 128 + m * 16;
            f32x4 v = (f32x4){0.f, 0.f, 0.f, 0.f};
            if (fq < R.n4) v = *(const f32x4*)(R.ssq + (size_t)row * R.stride + R.off + 4 * fq);
            float s = (v[0] + v[1]) + (v[2] + v[3]);
            s += xor_lane<16>(s); s = xhalf_sum(s);
            rs[ai][m] = rsqrtf(s * R.inv_dim + EPSN);
        }
}
__device__ __forceinline__ float dot4(f32x4 v) { return (v[0] * v[0] + v[1] * v[1]) + (v[2] * v[2] + v[3] * v[3]); }

struct EpiBf16S {
    static constexpr bool PERM = true, ACC_INIT = false;
    bf16_t* O; int ldc; RowScale R; int scale_tiles; float scale0;
    __device__ __forceinline__ void operator()(const AccT& acc, const pg8::Unit& u, int wr, int wc, int fr, int fq) const {
        const int row0 = u.pm * 256 + wr * 64 + fr;
        float rs[2][4]; load_rstd(rs, R, row0, fq);
        const float sc = (u.pn < scale_tiles) ? scale0 : 1.f;
        const int col0 = u.pn * 256 + wc * 32 + 8 * fq;
#pragma unroll
        for (int ai = 0; ai < 2; ++ai)
#pragma unroll
            for (int m = 0; m < 4; ++m) { bf16_t* rowp = O + (size_t)(row0 + ai * 128 + m * 16) * ldc + col0; const float f = rs[ai][m] * sc;
#pragma unroll
                for (int bj = 0; bj < 2; ++bj) { const f32x4 v0 = acc[ai][bj][m][0] * f, v1 = acc[ai][bj][m][1] * f;
                    u32x4 w; w.x = cvt_pk_bf16(v0[0], v0[1]); w.y = cvt_pk_bf16(v0[2], v0[3]); w.z = cvt_pk_bf16(v1[0], v1[1]); w.w = cvt_pk_bf16(v1[2], v1[3]);
                    *(u32x4*)(rowp + bj * 128) = w; } }
    }
};

struct EpiQkvA {
    static constexpr bool PERM = true, ACC_INIT = false;
    bf16_t* Q; bf16_t* Kc; bf16_t* Vc; RowScale R; float scale0;
    __device__ __forceinline__ void operator()(const AccT& acc, const pg8::Unit& u, int wr, int wc, int fr, int fq) const {
        const int row0 = u.pm * 256 + wr * 64 + fr;
        float rs[2][4]; load_rstd(rs, R, row0, fq);
        const float sc = (u.pn < 4) ? scale0 : 1.f;
#pragma unroll
        for (int ai = 0; ai < 2; ++ai)
#pragma unroll
            for (int m = 0; m < 4; ++m) { const int row = row0 + ai * 128 + m * 16; const int b = row >> 11, key = row & 2047; const float f = rs[ai][m] * sc;
#pragma unroll
                for (int bj = 0; bj < 2; ++bj) { const f32x4 v0 = acc[ai][bj][m][0] * f, v1 = acc[ai][bj][m][1] * f;
                    u32x4 w; w.x = cvt_pk_bf16(v0[0], v0[1]); w.y = cvt_pk_bf16(v0[2], v0[3]); w.z = cvt_pk_bf16(v1[0], v1[1]); w.w = cvt_pk_bf16(v1[2], v1[3]);
                    const int cc = bj * 128 + wc * 32 + 8 * fq, kvh = cc >> 6, e6 = cc & 63;
                    bf16_t* dst;
                    if (u.pn < 4) dst = Q + (size_t)row * AQKV + u.pn * 256 + cc;
                    else if (u.pn == 4) dst = Kc + ((size_t)((b * 4 + kvh) * 8 + (e6 >> 3)) * SEQ + key) * 8;
                    else dst = Vc + ((size_t)((b * 4 + kvh) * 2 + (e6 >> 5)) * SEQ + key) * 32 + (e6 & 31);
                    *(u32x4*)dst = w; } }
    }
};
struct EpiKvB {
    static constexpr bool PERM = true, ACC_INIT = false;
    bf16_t* Kc; bf16_t* Vc; RowScale R;
    __device__ __forceinline__ void operator()(const AccT& acc, const pg8::Unit& u, int wr, int wc, int fr, int fq) const {
        const int row0 = u.pm * 256 + wr * 64 + fr;
        float rs[2][4]; load_rstd(rs, R, row0, fq);
        const int cc = wc * 32 + 8 * fq;
#pragma unroll
        for (int ai = 0; ai < 2; ++ai)
#pragma unroll
            for (int m = 0; m < 4; ++m) { const int row = row0 + ai * 128 + m * 16; const int b = row >> 11, key = row & 2047; const float f = rs[ai][m];
#pragma unroll
                for (int bj = 0; bj < 2; ++bj) { const f32x4 v0 = acc[ai][bj][m][0] * f, v1 = acc[ai][bj][m][1] * f;
                    u32x4 w; w.x = cvt_pk_bf16(v0[0], v0[1]); w.y = cvt_pk_bf16(v0[2], v0[3]); w.z = cvt_pk_bf16(v1[0], v1[1]); w.w = cvt_pk_bf16(v1[2], v1[3]);
                    const int h = u.pn * 2 + bj;
                    bf16_t* dst;
                    if (wc < 2) dst = Kc + ((size_t)((b * 16 + h) * 8 + (cc >> 3)) * SEQ + key) * 8;
                    else dst = Vc + ((size_t)((b * 16 + h) * 2 + ((cc - 64) >> 5)) * SEQ + key) * 32 + ((cc - 64) & 31);
                    *(u32x4*)dst = w; } }
    }
};
__device__ __forceinline__ float silu_mul(float g, float u) { return g * __builtin_amdgcn_rcpf(1.f + __expf(-g)) * u; }
struct EpiSwiglu {
    static constexpr bool PERM = true, ACC_INIT = false;
    bf16_t* O; RowScale R;
    __device__ __forceinline__ void operator()(const AccT& acc, const pg8::Unit& u, int wr, int wc, int fr, int fq) const {
        const int row0 = u.pm * 256 + wr * 64 + fr;
        float rs[2][4]; load_rstd(rs, R, row0, fq);
        const int col0 = u.pn * 128 + wc * 32 + 8 * fq;
#pragma unroll
        for (int ai = 0; ai < 2; ++ai)
#pragma unroll
            for (int m = 0; m < 4; ++m) { bf16_t* rowp = O + (size_t)(row0 + ai * 128 + m * 16) * DFF + col0; const float f = rs[ai][m];
                const f32x4 g0 = acc[ai][0][m][0] * f, g1 = acc[ai][0][m][1] * f, u0 = acc[ai][1][m][0] * f, u1 = acc[ai][1][m][1] * f;
                u32x4 w; w.x = cvt_pk_bf16(silu_mul(g0[0], u0[0]), silu_mul(g0[1], u0[1])); w.y = cvt_pk_bf16(silu_mul(g0[2], u0[2]), silu_mul(g0[3], u0[3]));
                w.z = cvt_pk_bf16(silu_mul(g1[0], u1[0]), silu_mul(g1[1], u1[1])); w.w = cvt_pk_bf16(silu_mul(g1[2], u1[2]), silu_mul(g1[3], u1[3]));
                *(u32x4*)rowp = w; }
    }
};
struct EpiResid {
    static constexpr bool PERM = true, ACC_INIT = true;
    bf16_t* hb; float* ssq;
    __device__ __forceinline__ void init(AccT& acc, const pg8::Unit& u, int wr, int wc, int fr, int fq) const {
        const int row0 = u.pm * 256 + wr * 64 + fr; const int col0 = u.pn * 256 + wc * 32 + 8 * fq;
#pragma unroll
        for (int ai = 0; ai < 2; ++ai)
#pragma unroll
            for (int m = 0; m < 4; ++m) { const bf16_t* rp = hb + (size_t)(row0 + ai * 128 + m * 16) * DM + col0;
#pragma unroll
                for (int bj = 0; bj < 2; ++bj) { const u32x4 o = *(const u32x4*)(rp + bj * 128);
                    acc[ai][bj][m][0] = (f32x4){__uint_as_float(o.x << 16), __uint_as_float(o.x & 0xffff0000u), __uint_as_float(o.y << 16), __uint_as_float(o.y & 0xffff0000u)};
                    acc[ai][bj][m][1] = (f32x4){__uint_as_float(o.z << 16), __uint_as_float(o.z & 0xffff0000u), __uint_as_float(o.w << 16), __uint_as_float(o.w & 0xffff0000u)}; } }
    }
    __device__ __forceinline__ void operator()(const AccT& acc, const pg8::Unit& u, int wr, int wc, int fr, int fq) const {
        const int row0 = u.pm * 256 + wr * 64 + fr; const int col0 = u.pn * 256 + wc * 32 + 8 * fq;
#pragma unroll
        for (int ai = 0; ai < 2; ++ai)
#pragma unroll
            for (int m = 0; m < 4; ++m) { const int row = row0 + ai * 128 + m * 16; bf16_t* rp = hb + (size_t)row * DM + col0; float ss = 0.f;
#pragma unroll
                for (int bj = 0; bj < 2; ++bj) { const f32x4 v0 = acc[ai][bj][m][0], v1 = acc[ai][bj][m][1];
                    ss += dot4(v0) + dot4(v1);
                    u32x4 w; w.x = cvt_pk_bf16(v0[0], v0[1]); w.y = cvt_pk_bf16(v0[2], v0[3]); w.z = cvt_pk_bf16(v1[0], v1[1]); w.w = cvt_pk_bf16(v1[2], v1[3]);
                    *(u32x4*)(rp + bj * 128) = w; }
                ss += xor_lane<16>(ss); ss = xhalf_sum(ss);
                if (fq == 0) ssq[(size_t)row * 16 + u.pn * 4 + wc] = ss; }
    }
};
struct EpiLat {
    static constexpr bool PERM = false, ACC_INIT = false;
    bf16_t* lat; float* ssql; bf16_t* kr; const float* cosT; const float* sinT; RowScale R;
    __device__ __forceinline__ void operator()(const AccT& acc, const pg8::Unit& u, int wr, int wc, int fr, int fq) const {
        const int row0 = u.pm * 256 + wr * 64 + fr; const int col0 = u.pn * 256 + wc * 32 + 4 * fq;
        float rs[2][4]; load_rstd(rs, R, row0, fq);
#pragma unroll
        for (int ai = 0; ai < 2; ++ai)
#pragma unroll
            for (int m = 0; m < 4; ++m) { const int row = row0 + ai * 128 + m * 16; const float f = rs[ai][m];
#pragma unroll
                for (int bj = 0; bj < 2; ++bj) { float ss = 0.f;
#pragma unroll
                    for (int n = 0; n < 2; ++n) { const f32x4 v = acc[ai][bj][m][n] * f; ss += dot4(v); u32x2 w; w.x = cvt_pk_bf16(v[0], v[1]); w.y = cvt_pk_bf16(v[2], v[3]);
                        *(u32x2*)(lat + (size_t)row * BINP + col0 + bj * 128 + n * 16) = w; }
                    ss += xor_lane<16>(ss); ss = xhalf_sum(ss);
                    if (fq == 0) ssql[(size_t)row * 24 + u.pn * 8 + bj * 4 + wc] = ss; }
                if (u.pn == 2 && wc == 0) { const f32x4 t1 = acc[ai][1][m][0] * f, t2 = acc[ai][1][m][1] * f;
                    const f32x4 c = *(const f32x4*)(cosT + (size_t)row * 16 + 4 * fq), s = *(const f32x4*)(sinT + (size_t)row * 16 + 4 * fq);
                    const f32x4 o1 = t1 * c - t2 * s, o2 = t1 * s + t2 * c; u32x2 w1, w2; w1.x = cvt_pk_bf16(o1[0], o1[1]); w1.y = cvt_pk_bf16(o1[2], o1[3]); w2.x = cvt_pk_bf16(o2[0], o2[1]); w2.y = cvt_pk_bf16(o2[2], o2[3]);
                    const int b = row >> 11, key = row & 2047; bf16_t* kd = kr + ((size_t)(b * 4 + (fq >> 1)) * SEQ + key) * 8 + 4 * (fq & 1); *(u32x2*)kd = w1; *(u32x2*)(kd + (size_t)2 * SEQ * 8) = w2; } }
    }
};
struct EpiUq {
    static constexpr bool PERM = false, ACC_INIT = false;
    bf16_t* qm; const float* cosT; const float* sinT; RowScale R; float qscale;
    __device__ __forceinline__ void operator()(const AccT& acc, const pg8::Unit& u, int wr, int wc, int fr, int fq) const {
        const int row0 = u.pm * 256 + wr * 64 + fr; const int col0 = u.pn * 256 + wc * 32 + 4 * fq;
        float rs[2][4]; load_rstd(rs, R, row0, fq);
        const int G0 = u.pn * 8 + wc; const bool rp0 = (G0 % 3) == 2, rp1 = ((G0 + 4) % 3) == 2;
#pragma unroll
        for (int ai = 0; ai < 2; ++ai)
#pragma unroll
            for (int m = 0; m < 4; ++m) { const int row = row0 + ai * 128 + m * 16; const float f = rs[ai][m] * qscale;
                f32x4 c = (f32x4){1.f, 1.f, 1.f, 1.f}, s = (f32x4){0.f, 0.f, 0.f, 0.f};
                if (rp0 || rp1) { c = *(const f32x4*)(cosT + (size_t)row * 16 + 4 * fq); s = *(const f32x4*)(sinT + (size_t)row * 16 + 4 * fq); }
#pragma unroll
                for (int bj = 0; bj < 2; ++bj) { f32x4 v0 = acc[ai][bj][m][0] * f, v1 = acc[ai][bj][m][1] * f;
                    if (bj == 0 ? rp0 : rp1) { const f32x4 a = v0 * c - v1 * s, b = v0 * s + v1 * c; v0 = a; v1 = b; }
                    u32x2 w0, w1; w0.x = cvt_pk_bf16(v0[0], v0[1]); w0.y = cvt_pk_bf16(v0[2], v0[3]); w1.x = cvt_pk_bf16(v1[0], v1[1]); w1.y = cvt_pk_bf16(v1[2], v1[3]);
                    bf16_t* p = qm + (size_t)row * UQ + col0 + bj * 128; *(u32x2*)p = w0; *(u32x2*)(p + 16) = w1; } }
    }
};

__device__ __forceinline__ s16x4 vtr(const LAS unsigned char* p) { typedef short v4i16_t __attribute__((ext_vector_type(4))); return __builtin_bit_cast(s16x4, __builtin_amdgcn_ds_read_tr16_b64_v4i16((LAS v4i16_t*)p)); }

template <int DQK, bool WIN>
__device__ __forceinline__ void attn_unit(LAS unsigned char* lds, const bf16_t* __restrict__ Qp, int ldq, const bf16_t* __restrict__ Kp, int ldk, const bf16_t* __restrict__ KRp,
                                          const bf16_t* __restrict__ Vp, int ldv, bf16_t* Op, int ldo, const int* __restrict__ posb, int q0, float slope2, float sink2, const int wave_s) {
    constexpr int KS = DQK * 2 + 16, KBYTES = 64 * KS, VOFF = 2 * KBYTES, VBYTES = 8192, NKS = DQK / 16;
    const int tid = tid_from_wave(wave_s);
    const int lane = tid & 63, r32 = lane & 31, hh = lane >> 5;
    const int wid = __builtin_amdgcn_readfirstlane(tid >> 6);
    const int qw0 = q0 + wid * 32;
    int kbeg = 0, kend = SEQ;
    if (WIN) { kbeg = q0 - 128 < 0 ? 0 : q0 - 128; kend = q0 + 384 > SEQ ? SEQ : q0 + 384; }
    const int NT = (kend - kbeg) >> 6;
    bf16x8 qf[NKS];
#pragma unroll
    for (int ks = 0; ks < NKS; ++ks) qf[ks] = *(const bf16x8*)(Qp + (size_t)(qw0 + r32) * ldq + ks * 16 + hh * 8);
    const int skey = tid >> 3, sc8 = tid & 7;
    const bf16_t* kg = Kp + (size_t)(kbeg + skey) * ldk + sc8 * 8;
    const bf16_t* vg = Vp + (size_t)(kbeg + skey) * ldv + sc8 * 8;
    const int kl = skey * KS + sc8 * 16;
    const int vl = VOFF + ((skey >> 3) * 2 + (sc8 >> 2)) * 512 + (skey & 7) * 64 + (sc8 & 3) * 16;
    const bf16_t* krg = KRp + (size_t)(kbeg + (tid >> 2)) * 32 + (tid & 3) * 8;
    const int krl = (tid >> 2) * KS + 128 + (tid & 3) * 16;
    const bool has_kr = (DQK == 96) && (tid < 256);
    u32x4 kreg, vreg, krreg = (u32x4){0u, 0u, 0u, 0u};
    kreg = *(const u32x4*)kg; vreg = *(const u32x4*)vg; if (has_kr) krreg = *(const u32x4*)krg;
    *(LAS u32x4*)(lds + kl) = kreg; *(LAS u32x4*)(lds + vl) = vreg; if (has_kr) *(LAS u32x4*)(lds + krl) = krreg;
    __syncthreads();
    float mrun = WIN ? sink2 : -1e30f, lrun = (WIN && hh == 0) ? 1.f : 0.f;
    f32x16 o0, o1;
#pragma unroll
    for (int i = 0; i < 16; ++i) { o0[i] = 0.f; o1[i] = 0.f; }
    const int qi = qw0 + r32; int qpos = 0; if (WIN) qpos = posb[qi];
    const int vlane = (4 * hh + ((lane & 15) >> 2)) * 64 + ((lane >> 4) & 1) * 32 + (lane & 3) * 8;
    for (int t = 0; t < NT; ++t) {
        const int buf = t & 1;
        if (t + 1 < NT) { kreg = *(const u32x4*)(kg + (size_t)(t + 1) * 64 * ldk); vreg = *(const u32x4*)(vg + (size_t)(t + 1) * 64 * ldv); if (has_kr) krreg = *(const u32x4*)(krg + (size_t)(t + 1) * 64 * 32); }
        const int k0 = kbeg + 64 * t;
        const bool active = !WIN || (k0 + 63 >= qw0 - 128 && k0 <= qw0 + 31 + 128);
        if (active) {
            const LAS unsigned char* Kb = lds + buf * KBYTES + r32 * KS + hh * 16;
            f32x16 s0, s1;
#pragma unroll
            for (int i = 0; i < 16; ++i) { s0[i] = 0.f; s1[i] = 0.f; }
#pragma unroll
            for (int ks = 0; ks < NKS; ++ks) {
                const bf16x8 a0 = *(const LAS bf16x8*)(Kb + ks * 32);
                const bf16x8 a1 = *(const LAS bf16x8*)(Kb + 32 * KS + ks * 32);
                s0 = __builtin_amdgcn_mfma_f32_32x32x16_bf16(a0, qf[ks], s0, 0, 0, 0);
                s1 = __builtin_amdgcn_mfma_f32_32x32x16_bf16(a1, qf[ks], s1, 0, 0, 0);
            }
            if (WIN) {
#pragma unroll
                for (int gq = 0; gq < 4; ++gq) {
                    const int kb0 = k0 + 8 * gq + 4 * hh;
                    const i32x4 kp0 = *(const i32x4*)(posb + kb0), kp1 = *(const i32x4*)(posb + kb0 + 32);
#pragma unroll
                    for (int e = 0; e < 4; ++e) { const int i = 4 * gq + e; const int d0 = kb0 + e - qi, d1 = d0 + 32;
                        const int p0 = kp0[e] - qpos, p1 = kp1[e] - qpos;
                        const float f0 = (float)(p0 < 0 ? -p0 : p0), f1 = (float)(p1 < 0 ? -p1 : p1);
                        s0[i] = (d0 >= -128 && d0 <= 128) ? (s0[i] - slope2 * f0) : -1e30f;
                        s1[i] = (d1 >= -128 && d1 <= 128) ? (s1[i] - slope2 * f1) : -1e30f; }
                }
            }
            float mx = fmaxf(s0[0], s1[0]);
#pragma unroll
            for (int i = 1; i < 16; ++i) mx = fmaxf(mx, fmaxf(s0[i], s1[i]));
            mx = xhalf_max(mx);
            const float mnew = fmaxf(mrun, mx);
            const float alpha = __builtin_amdgcn_exp2f(mrun - mnew);
            mrun = mnew;
            float ps = 0.f;
#pragma unroll
            for (int i = 0; i < 16; ++i) { s0[i] = __builtin_amdgcn_exp2f(s0[i] - mnew); s1[i] = __builtin_amdgcn_exp2f(s1[i] - mnew); ps += s0[i] + s1[i]; }
            lrun = lrun * alpha + ps;
#pragma unroll
            for (int i = 0; i < 16; ++i) { o0[i] *= alpha; o1[i] *= alpha; }
            bf16x8 pk[4];
#pragma unroll
            for (int s = 0; s < 4; ++s) { u32x4 w;
                if (s < 2) { const int b = 8 * s; w.x = cvt_pk_bf16(s0[b], s0[b + 1]); w.y = cvt_pk_bf16(s0[b + 2], s0[b + 3]); w.z = cvt_pk_bf16(s0[b + 4], s0[b + 5]); w.w = cvt_pk_bf16(s0[b + 6], s0[b + 7]); }
                else { const int b = 8 * (s - 2); w.x = cvt_pk_bf16(s1[b], s1[b + 1]); w.y = cvt_pk_bf16(s1[b + 2], s1[b + 3]); w.z = cvt_pk_bf16(s1[b + 4], s1[b + 5]); w.w = cvt_pk_bf16(s1[b + 6], s1[b + 7]); }
                pk[s] = __builtin_bit_cast(bf16x8, w); }
            const LAS unsigned char* vb = lds + VOFF + buf * VBYTES + vlane;
#pragma unroll
            for (int s = 0; s < 4; ++s) {
                const s16x4 l0 = vtr(vb + (4 * s + 0) * 512), h0 = vtr(vb + (4 * s + 2) * 512);
                const s16x4 l1 = vtr(vb + (4 * s + 1) * 512), h1 = vtr(vb + (4 * s + 3) * 512);
                const bf16x8 v0 = (bf16x8){l0[0], l0[1], l0[2], l0[3], h0[0], h0[1], h0[2], h0[3]};
                const bf16x8 v1 = (bf16x8){l1[0], l1[1], l1[2], l1[3], h1[0], h1[1], h1[2], h1[3]};
                o0 = __builtin_amdgcn_mfma_f32_32x32x16_bf16(v0, pk[s], o0, 0, 0, 0);
                o1 = __builtin_amdgcn_mfma_f32_32x32x16_bf16(v1, pk[s], o1, 0, 0, 0);
            }
        }
        if (t + 1 < NT) { const int nb = buf ^ 1; *(LAS u32x4*)(lds + nb * KBYTES + kl) = kreg; *(LAS u32x4*)(lds + nb * VBYTES + vl) = vreg; if (has_kr) *(LAS u32x4*)(lds + nb * KBYTES + krl) = krreg; }
        __syncthreads();
    }
    const float inv = 1.f / xhalf_sum(lrun);
    bf16_t* orow = Op + (size_t)qi * ldo + 4 * hh;
#pragma unroll
    for (int gq = 0; gq < 4; ++gq) {
        u32x2 w0, w1;
        w0.x = cvt_pk_bf16(o0[4 * gq] * inv, o0[4 * gq + 1] * inv); w0.y = cvt_pk_bf16(o0[4 * gq + 2] * inv, o0[4 * gq + 3] * inv);
        w1.x = cvt_pk_bf16(o1[4 * gq] * inv, o1[4 * gq + 1] * inv); w1.y = cvt_pk_bf16(o1[4 * gq + 2] * inv, o1[4 * gq + 3] * inv);
        *(u32x2*)(orow + 8 * gq) = w0; *(u32x2*)(orow + 32 + 8 * gq) = w1;
    }
}


#define AT_WAIT_V(n) asm volatile("s_waitcnt vmcnt(" #n ")" ::: "memory")
#define AT_WAIT_L0() asm volatile("s_waitcnt lgkmcnt(0)" ::: "memory")
#define AT_BAR() do { __builtin_amdgcn_s_barrier(); asm volatile("" ::: "memory"); } while (0)
#define AT_DMA(gp, lp) __builtin_amdgcn_global_load_lds((const unsigned*)(gp), (LAS unsigned*)(lp), 16, 0, 0)
template <int DQK, bool WIN>
__device__ __forceinline__ void attn_unit2(LAS unsigned char* lds, const bf16_t* __restrict__ Qp, int ldq, const bf16_t* __restrict__ Kc, const bf16_t* __restrict__ KRc,
                                           const bf16_t* __restrict__ Vc, bf16_t* Op, int ldo, const float* __restrict__ posfb, int q0, int hbase, const float* __restrict__ sinkp, const int wave_s,
                                           const bf16_t* __restrict__ nKc, const bf16_t* __restrict__ nKRc, const bf16_t* __restrict__ nVc, int nq0, int flags, int& so_io) {
    constexpr int NCH = DQK / 8, KB = NCH * 2048, SB = KB + 16384, POSOFF = 3 * SB, NKS = DQK / 16;
    static_assert(POSOFF + 2048 <= 131072, "attention LDS");
    const int tid = tid_from_wave(wave_s);
    const int lane = tid & 63, r32 = lane & 31, hh = lane >> 5;
    const int wid = __builtin_amdgcn_readfirstlane(tid >> 6);
    const int qw0 = WIN ? q0 + (wid & 1) * 32 : q0 + wid * 32, qi = qw0 + r32;
    int kbeg = 0, kend = SEQ;
    if (WIN) { kbeg = q0 - 128 < 0 ? 0 : q0 - 128; kend = q0 + 192 > SEQ ? SEQ : q0 + 192; Qp += (wid >> 1) * 64; Op += (wid >> 1) * 64; }
    const int NT = (kend - kbeg + 127) >> 7;
    float slope2 = 0.f, sink2 = 0.f;
    if (WIN) { const int h = hbase + (wid >> 1); slope2 = exp2f(-0.5f * (float)(h + 1)) * LOG2E; sink2 = sinkp[h] * LOG2E; }
    const int dmax = (SEQ - 1 - qi + 128) < 256 ? (SEQ - 1 - qi + 128) : 256;
    int nkbeg = 0, nNT = SEQ >> 7;
    if (WIN) { nkbeg = nq0 - 128 < 0 ? 0 : nq0 - 128; const int nkend = nq0 + 192 > SEQ ? SEQ : nq0 + 192; nNT = (nkend - nkbeg + 127) >> 7; }
    LAS unsigned char* kdst = lds + wid * 2048;
    LAS unsigned char* krdst = lds + (8 + (wid >> 1)) * 2048 + (wid & 1) * 1024;
    LAS unsigned char* vdst = lds + KB + wid * 1024;
#define AT_STAGE_U(KC, KRC, VC, KBEG, t, so) do { const int _k0 = (KBEG) + (t) * 128; \
        if (WIN) {   \
            const int _ka = _k0 + lane, _kb = _ka + 64, _kv = _k0 + 16 * wid + (lane >> 2); \
            const bf16_t* _k = (KC) + (size_t)wid * SEQ * 8; const bf16_t* _v = (VC) + (lane & 3) * 8 + (size_t)(_kv < SEQ ? _kv : SEQ - 1) * 32; \
            AT_DMA(_k + (size_t)(_ka < SEQ ? _ka : SEQ - 1) * 8, kdst + (so)); AT_DMA(_k + (size_t)(_kb < SEQ ? _kb : SEQ - 1) * 8, kdst + (so) + 1024); \
            AT_DMA(_v, vdst + (so)); AT_DMA(_v + (size_t)SEQ * 32, vdst + (so) + 8192); \
        } else { \
            const bf16_t* _k = (KC) + ((size_t)wid * SEQ + _k0 + lane) * 8; const bf16_t* _kr = (KRC) + ((size_t)(wid >> 1) * SEQ + _k0 + 64 * (wid & 1) + lane) * 8; \
            const bf16_t* _v = (VC) + (size_t)(_k0 + 16 * wid) * 32 + lane * 8; \
            AT_DMA(_k, kdst + (so)); AT_DMA(_k + 64 * 8, kdst + (so) + 1024); AT_DMA(_kr, krdst + (so)); \
            AT_DMA(_v, vdst + (so)); AT_DMA(_v + (size_t)SEQ * 32, vdst + (so) + 8192); } } while (0)
    int so = so_io;
    if (wid < 4) __builtin_amdgcn_s_setprio(2);
    if (!(flags & 1)) { AT_WAIT_V(0); AT_STAGE_U(Kc, KRc, Vc, kbeg, 0, so); if (NT > 1) { const int s1 = so >= 2 * SB ? 0 : so + SB; AT_STAGE_U(Kc, KRc, Vc, kbeg, 1, s1); } }
    float qposf = 0.f;
    if (WIN) { if (tid < kend - kbeg) *(LAS float*)(lds + POSOFF + tid * 4) = posfb[kbeg + tid]; qposf = posfb[qi]; }
    bf16x8 qf[NKS];
#pragma unroll
    for (int ks = 0; ks < NKS; ++ks) qf[ks] = *(const bf16x8*)(Qp + (size_t)qi * ldq + ks * 16 + hh * 8);
    float mref = WIN ? sink2 : 0.f, lrun = (WIN && hh == 0) ? 1.f : 0.f;
    f32x16 o0, o1, negm;
#pragma unroll
    for (int i = 0; i < 16; ++i) { o0[i] = 0.f; o1[i] = 0.f; negm[i] = -mref; }
    const int vlane = (4 * hh + ((lane & 15) >> 2)) * 64 + ((lane >> 4) & 1) * 32 + (lane & 3) * 8;
    for (int t = 0; t < NT; ++t) {
        if ((t + 1 < NT) || ((flags & 2) && (t + 1 - NT) < nNT)) { if (DQK == 96) AT_WAIT_V(5); else AT_WAIT_V(4); } else AT_WAIT_V(0);
        AT_WAIT_L0(); AT_BAR();
        { const int s2 = so >= SB ? so - SB : so + 2 * SB;
          if (t + 2 < NT) AT_STAGE_U(Kc, KRc, Vc, kbeg, t + 2, s2);
          else if ((flags & 2) && (t + 2 - NT) < nNT) AT_STAGE_U(nKc, nKRc, nVc, nkbeg, t + 2 - NT, s2); }
        const int k0 = kbeg + 128 * t;
        const bool active = !WIN || (k0 + 127 >= qw0 - 128 && k0 <= qw0 + 159);
        if (active) {
            if constexpr (!WIN) {
            const LAS unsigned char* Kb = lds + so + hh * 2048 + r32 * 16;
            const LAS unsigned char* vb = lds + so + KB + vlane;
            bf16x8 kf[2 * NKS];
#pragma unroll
            for (int ks = 0; ks < NKS; ++ks) { kf[2 * ks] = *(const LAS bf16x8*)(Kb + ks * 4096); kf[2 * ks + 1] = *(const LAS bf16x8*)(Kb + ks * 4096 + 512); }
            __builtin_amdgcn_sched_barrier(0);
            f32x16 s0a, s0b, s1a, s1b;
#pragma unroll
            for (int ks = 0; ks < NKS; ++ks) {
                s0a = __builtin_amdgcn_mfma_f32_32x32x16_bf16(kf[2 * ks], qf[ks], ks == 0 ? negm : s0a, 0, 0, 0);
                s0b = __builtin_amdgcn_mfma_f32_32x32x16_bf16(kf[2 * ks + 1], qf[ks], ks == 0 ? negm : s0b, 0, 0, 0);
            }
            __builtin_amdgcn_sched_barrier(0);
#pragma unroll
            for (int ks = 0; ks < NKS; ++ks) { kf[2 * ks] = *(const LAS bf16x8*)(Kb + ks * 4096 + 1024); kf[2 * ks + 1] = *(const LAS bf16x8*)(Kb + ks * 4096 + 1536); }
            s16x4 vl0[4], vh0[4], vl1[4], vh1[4];
#pragma unroll
            for (int j = 0; j < 4; ++j) { vl0[j] = vtr(vb + j * 1024); vh0[j] = vtr(vb + j * 1024 + 512); }
            __builtin_amdgcn_sched_barrier(0);
#define AT_ROWMAX(sa, sb, rm) do { rm = __builtin_fmaxf(sa[0], sb[0]); _Pragma("unroll") for (int i = 1; i < 16; ++i) rm = __builtin_fmaxf(__builtin_fmaxf(rm, sa[i]), sb[i]); rm = xhalf_max(rm); } while (0)
#define AT_RESCALE(sa, sb, rm, first) do { if ((first) || __any(rm > 8.f)) { const float dl = (first) ? rm : fmaxf(rm, 0.f); mref += dl; const float al = (first) ? 1.f : __builtin_amdgcn_exp2f(-dl); lrun *= al; \
                _Pragma("unroll") for (int i = 0; i < 16; ++i) { negm[i] = -mref; o0[i] *= al; o1[i] *= al; sa[i] -= dl; sb[i] -= dl; } asm volatile("" : "+v"(negm)); } } while (0)
#define AT_EXPPACK(sa, sb, pk) do { float ps0 = 0.f, ps1 = 0.f; _Pragma("unroll") for (int i = 0; i < 16; ++i) { sa[i] = __builtin_amdgcn_exp2f(sa[i]); sb[i] = __builtin_amdgcn_exp2f(sb[i]); ps0 += sa[i]; ps1 += sb[i]; } lrun += ps0 + ps1; \
                _Pragma("unroll") for (int j = 0; j < 4; ++j) { u32x4 w; const int b = 8 * (j & 1); \
                    if (j < 2) { w.x = cvt_pk_bf16(sa[b], sa[b + 1]); w.y = cvt_pk_bf16(sa[b + 2], sa[b + 3]); w.z = cvt_pk_bf16(sa[b + 4], sa[b + 5]); w.w = cvt_pk_bf16(sa[b + 6], sa[b + 7]); } \
                    else { w.x = cvt_pk_bf16(sb[b], sb[b + 1]); w.y = cvt_pk_bf16(sb[b + 2], sb[b + 3]); w.z = cvt_pk_bf16(sb[b + 4], sb[b + 5]); w.w = cvt_pk_bf16(sb[b + 6], sb[b + 7]); } \
                    pk[j] = __builtin_bit_cast(bf16x8, w); } } while (0)
#define AT_VF(lo, hi, j) ((bf16x8){lo[j][0], lo[j][1], lo[j][2], lo[j][3], hi[j][0], hi[j][1], hi[j][2], hi[j][3]})
            float rm0; AT_ROWMAX(s0a, s0b, rm0);
            AT_RESCALE(s0a, s0b, rm0, (t == 0));
            __builtin_amdgcn_sched_barrier(0);
            bf16x8 pk0[4];
#pragma unroll
            for (int ks = 0; ks < NKS; ++ks) {
                s1a = __builtin_amdgcn_mfma_f32_32x32x16_bf16(kf[2 * ks], qf[ks], ks == 0 ? negm : s1a, 0, 0, 0);
                s1b = __builtin_amdgcn_mfma_f32_32x32x16_bf16(kf[2 * ks + 1], qf[ks], ks == 0 ? negm : s1b, 0, 0, 0);
            }
            AT_EXPPACK(s0a, s0b, pk0);
#pragma unroll
            for (int g = 0; g < 2 * NKS; ++g) { __builtin_amdgcn_sched_group_barrier(0x008, 1, 0); __builtin_amdgcn_sched_group_barrier(0x400, 3, 0); __builtin_amdgcn_sched_group_barrier(0x002, 4, 0); }
            __builtin_amdgcn_sched_barrier(0);
#pragma unroll
            for (int j = 0; j < 4; ++j) { vl1[j] = vtr(vb + 8192 + j * 1024); vh1[j] = vtr(vb + 8192 + j * 1024 + 512); }
            __builtin_amdgcn_sched_barrier(0);
            float rm1;
#pragma unroll
            for (int j = 0; j < 4; ++j) o0 = __builtin_amdgcn_mfma_f32_32x32x16_bf16(AT_VF(vl0, vh0, j), pk0[j], o0, 0, 0, 0);
#pragma unroll
            for (int j = 0; j < 4; ++j) o1 = __builtin_amdgcn_mfma_f32_32x32x16_bf16(AT_VF(vl1, vh1, j), pk0[j], o1, 0, 0, 0);
            AT_ROWMAX(s1a, s1b, rm1);
#pragma unroll
            for (int g = 0; g < 8; ++g) { __builtin_amdgcn_sched_group_barrier(0x008, 1, 0); __builtin_amdgcn_sched_group_barrier(0x002, 3, 0); }
            __builtin_amdgcn_sched_barrier(0);
            AT_RESCALE(s1a, s1b, rm1, false);
#pragma unroll
            for (int j = 0; j < 4; ++j) { vl0[j] = vtr(vb + (4 + j) * 1024); vh0[j] = vtr(vb + (4 + j) * 1024 + 512); }
            __builtin_amdgcn_sched_barrier(0);
            bf16x8 pk1[4];
            AT_EXPPACK(s1a, s1b, pk1);
#pragma unroll
            for (int j = 0; j < 4; ++j) { vl1[j] = vtr(vb + 8192 + (4 + j) * 1024); vh1[j] = vtr(vb + 8192 + (4 + j) * 1024 + 512); }
            __builtin_amdgcn_sched_barrier(0);
#pragma unroll
            for (int j = 0; j < 4; ++j) o0 = __builtin_amdgcn_mfma_f32_32x32x16_bf16(AT_VF(vl0, vh0, j), pk1[j], o0, 0, 0, 0);
#pragma unroll
            for (int j = 0; j < 4; ++j) o1 = __builtin_amdgcn_mfma_f32_32x32x16_bf16(AT_VF(vl1, vh1, j), pk1[j], o1, 0, 0, 0);
#undef AT_ROWMAX
#undef AT_RESCALE
#undef AT_EXPPACK
#undef AT_VF
            } else {
            const LAS unsigned char* Kb = lds + so + hh * 2048 + r32 * 16;
            const LAS unsigned char* vb = lds + so + KB + vlane;
            bf16x8 kf[2 * NKS];
            bool have = false;
#pragma unroll
            for (int h = 0; h < 2; ++h) {
                if (WIN && !(k0 + 64 * h + 63 >= qw0 - 128 && k0 + 64 * h <= qw0 + 159 && k0 + 64 * h < kend)) { have = false; continue; }
                if (!have) {
#pragma unroll
                    for (int ks = 0; ks < NKS; ++ks) { kf[2 * ks] = *(const LAS bf16x8*)(Kb + ks * 4096 + h * 1024); kf[2 * ks + 1] = *(const LAS bf16x8*)(Kb + ks * 4096 + h * 1024 + 512); }
                }
                __builtin_amdgcn_sched_barrier(0);
                f32x16 sa, sb;
#pragma unroll
                for (int ks = 0; ks < NKS; ++ks) {
                    sa = __builtin_amdgcn_mfma_f32_32x32x16_bf16(kf[2 * ks], qf[ks], ks == 0 ? negm : sa, 0, 0, 0);
                    sb = __builtin_amdgcn_mfma_f32_32x32x16_bf16(kf[2 * ks + 1], qf[ks], ks == 0 ? negm : sb, 0, 0, 0);
                }
                __builtin_amdgcn_sched_barrier(0);
                s16x4 vl0[4], vh0[4], vl1[4], vh1[4];
#pragma unroll
                for (int j = 0; j < 4; ++j) { const int s16 = 4 * h + j; vl0[j] = vtr(vb + s16 * 1024); vh0[j] = vtr(vb + s16 * 1024 + 512); }
                __builtin_amdgcn_sched_barrier(0);
                if (WIN) {
                    const int kh0 = k0 + 64 * h;
                    const bool full = (kh0 >= qw0 - 97) && (kh0 + 63 <= qw0 + 128) && (kh0 + 63 < SEQ);
                    const LAS unsigned char* pb = lds + POSOFF + (kh0 - kbeg + 4 * hh) * 4;
#pragma unroll
                    for (int gq = 0; gq < 4; ++gq) {
                        const f32x4 kpa = *(const LAS f32x4*)(pb + (8 * gq) * 4), kpb = *(const LAS f32x4*)(pb + (32 + 8 * gq) * 4);
                        const int d0 = kh0 + 8 * gq + 4 * hh - qi + 128;
#pragma unroll
                        for (int e = 0; e < 4; ++e) { const int i = 4 * gq + e;
                            const float va = fmaf(-slope2, fabsf(kpa[e] - qposf), sa[i]), vb2 = fmaf(-slope2, fabsf(kpb[e] - qposf), sb[i]);
                            sa[i] = (full || (unsigned)(d0 + e) <= (unsigned)dmax) ? va : -1e30f;
                            sb[i] = (full || (unsigned)(d0 + 32 + e) <= (unsigned)dmax) ? vb2 : -1e30f; }
                    }
                }
                float rm = __builtin_fmaxf(sa[0], sb[0]);
#pragma unroll
                for (int i = 1; i < 16; ++i) rm = __builtin_fmaxf(__builtin_fmaxf(rm, sa[i]), sb[i]);
                rm = xhalf_max(rm);
                const bool first = !WIN && (t == 0) && (h == 0);
                if (first || __any(rm > 8.f)) {
                    const float dl = first ? rm : fmaxf(rm, 0.f);
                    mref += dl;
                    const float al = first ? 1.f : __builtin_amdgcn_exp2f(-dl);
                    lrun *= al;
#pragma unroll
                    for (int i = 0; i < 16; ++i) { negm[i] = -mref; o0[i] *= al; o1[i] *= al; sa[i] -= dl; sb[i] -= dl; }
                }
                float ps0 = 0.f, ps1 = 0.f;
#pragma unroll
                for (int i = 0; i < 16; ++i) { sa[i] = __builtin_amdgcn_exp2f(sa[i]); sb[i] = __builtin_amdgcn_exp2f(sb[i]); ps0 += sa[i]; ps1 += sb[i]; }
                lrun += ps0 + ps1;
                bf16x8 pk[4];
#pragma unroll
                for (int j = 0; j < 4; ++j) { u32x4 w; const int b = 8 * (j & 1);
                    if (j < 2) { w.x = cvt_pk_bf16(sa[b], sa[b + 1]); w.y = cvt_pk_bf16(sa[b + 2], sa[b + 3]); w.z = cvt_pk_bf16(sa[b + 4], sa[b + 5]); w.w = cvt_pk_bf16(sa[b + 6], sa[b + 7]); }
                    else { w.x = cvt_pk_bf16(sb[b], sb[b + 1]); w.y = cvt_pk_bf16(sb[b + 2], sb[b + 3]); w.z = cvt_pk_bf16(sb[b + 4], sb[b + 5]); w.w = cvt_pk_bf16(sb[b + 6], sb[b + 7]); }
                    pk[j] = __builtin_bit_cast(bf16x8, w); }
#pragma unroll
                for (int j = 0; j < 4; ++j) { const int s16 = 4 * h + j; vl1[j] = vtr(vb + 8192 + s16 * 1024); vh1[j] = vtr(vb + 8192 + s16 * 1024 + 512); }
                if (h == 0 && (!WIN || (k0 + 127 >= qw0 - 128 && k0 + 64 <= qw0 + 159 && k0 + 64 < kend))) {
#pragma unroll
                    for (int ks = 0; ks < NKS; ++ks) { kf[2 * ks] = *(const LAS bf16x8*)(Kb + ks * 4096 + 1024); kf[2 * ks + 1] = *(const LAS bf16x8*)(Kb + ks * 4096 + 1536); }
                    have = true;
                }
                __builtin_amdgcn_sched_barrier(0);
#pragma unroll
                for (int j = 0; j < 4; ++j) {
                    const bf16x8 v0 = (bf16x8){vl0[j][0], vl0[j][1], vl0[j][2], vl0[j][3], vh0[j][0], vh0[j][1], vh0[j][2], vh0[j][3]};
                    o0 = __builtin_amdgcn_mfma_f32_32x32x16_bf16(v0, pk[j], o0, 0, 0, 0);
                }
#pragma unroll
                for (int j = 0; j < 4; ++j) {
                    const bf16x8 v1 = (bf16x8){vl1[j][0], vl1[j][1], vl1[j][2], vl1[j][3], vh1[j][0], vh1[j][1], vh1[j][2], vh1[j][3]};
                    o1 = __builtin_amdgcn_mfma_f32_32x32x16_bf16(v1, pk[j], o1, 0, 0, 0);
                }
            }
                    }
        }
        so = so >= 2 * SB ? 0 : so + SB;
    }
    so_io = so;
    __builtin_amdgcn_s_setprio(0);
    AT_WAIT_L0(); AT_BAR();
    const float inv = 1.f / xhalf_sum(lrun);
    bf16_t* orow = Op + (size_t)qi * ldo + 8 * hh;
#pragma unroll
    for (int gp = 0; gp < 2; ++gp)
#pragma unroll
        for (int dh = 0; dh < 2; ++dh) {
            const int ga = 2 * gp, gb = 2 * gp + 1;
            unsigned ax, ay, bx2, by2;
            if (dh == 0) { ax = cvt_pk_bf16(o0[4 * ga] * inv, o0[4 * ga + 1] * inv); ay = cvt_pk_bf16(o0[4 * ga + 2] * inv, o0[4 * ga + 3] * inv); bx2 = cvt_pk_bf16(o0[4 * gb] * inv, o0[4 * gb + 1] * inv); by2 = cvt_pk_bf16(o0[4 * gb + 2] * inv, o0[4 * gb + 3] * inv); }
            else { ax = cvt_pk_bf16(o1[4 * ga] * inv, o1[4 * ga + 1] * inv); ay = cvt_pk_bf16(o1[4 * ga + 2] * inv, o1[4 * ga + 3] * inv); bx2 = cvt_pk_bf16(o1[4 * gb] * inv, o1[4 * gb + 1] * inv); by2 = cvt_pk_bf16(o1[4 * gb + 2] * inv, o1[4 * gb + 3] * inv); }
            const auto rx = __builtin_amdgcn_permlane32_swap(ax, bx2, false, false);
            const auto ry = __builtin_amdgcn_permlane32_swap(ay, by2, false, false);
            u32x4 w; w.x = rx[0]; w.y = ry[0]; w.z = rx[1]; w.w = ry[1];
            *(u32x4*)(orow + 32 * dh + 16 * gp) = w;
        }
#undef AT_STAGE_U
}


__device__ __forceinline__ void attn_win_cu(LAS unsigned char* lds, const bf16_t* __restrict__ Qp, int ldq, const bf16_t* __restrict__ Kc, const bf16_t* __restrict__ Vc, bf16_t* Op, int ldo,
                                            const float* __restrict__ posfb, int R0, int hbase, const float* __restrict__ sinkp, const int wave_s) {
    constexpr int VOFFW = 65536, POSW = 132096, NKS = 4;
    const int tid = tid_from_wave(wave_s);
    const int lane = tid & 63, r32 = lane & 31, hh = lane >> 5;
    const int wid = __builtin_amdgcn_readfirstlane(tid >> 6);
    const int kbase = R0 - 128;
    AT_WAIT_V(0);
#pragma unroll
    for (int g = 0; g < 8; ++g) { int k = kbase + 64 * g + lane; k = k < 0 ? 0 : (k >= SEQ ? SEQ - 1 : k);
        AT_DMA(Kc + ((size_t)wid * SEQ + k) * 8, lds + wid * 8192 + g * 1024); }
#pragma unroll
    for (int pce = 0; pce < 8; ++pce) { const int id = wid * 8 + pce, dh = id >> 5, blk = id & 31; int k = kbase + 16 * blk + (lane >> 2); k = k < 0 ? 0 : (k >= SEQ ? SEQ - 1 : k);
        AT_DMA(Vc + (size_t)dh * SEQ * 32 + (size_t)k * 32 + (lane & 3) * 8, lds + VOFFW + dh * 32768 + blk * 1024); }
    { int k = kbase + tid; k = k < 0 ? 0 : (k >= SEQ ? SEQ - 1 : k); *(LAS float*)(lds + POSW + tid * 4) = posfb[k]; }
    const int h = hbase + (wid >> 1);
    const float slope2 = exp2f(-0.5f * (float)(h + 1)) * LOG2E, sink2 = sinkp[h] * LOG2E;
    const int vlane = (4 * hh + ((lane & 15) >> 2)) * 64 + ((lane >> 4) & 1) * 32 + (lane & 3) * 8;
    AT_WAIT_V(0); AT_WAIT_L0(); AT_BAR();
    bf16x8 qf[NKS], qn[NKS];
#pragma unroll
    for (int ks = 0; ks < NKS; ++ks) qn[ks] = *(const bf16x8*)(Qp + (size_t)(R0 + 32 * (wid & 1) + r32) * ldq + (wid >> 1) * 64 + ks * 16 + hh * 8);
#pragma unroll 1
    for (int i = 0; i < 4; ++i) {
        const int qw0 = R0 + 64 * i + 32 * (wid & 1), qi = qw0 + r32;
        const int dmax = (SEQ - 1 - qi + 128) < 256 ? (SEQ - 1 - qi + 128) : 256;
#pragma unroll
        for (int ks = 0; ks < NKS; ++ks) qf[ks] = qn[ks];
        if (i < 3) {
#pragma unroll
            for (int ks = 0; ks < NKS; ++ks) qn[ks] = *(const bf16x8*)(Qp + (size_t)(qi + 64) * ldq + (wid >> 1) * 64 + ks * 16 + hh * 8);
        }
        const float qposf = *(const LAS float*)(lds + POSW + (qi - kbase) * 4);
        float mref = sink2, lrun = (hh == 0) ? 1.f : 0.f;
        f32x16 o0, o1, negm;
#pragma unroll
        for (int e = 0; e < 16; ++e) { o0[e] = 0.f; o1[e] = 0.f; negm[e] = -mref; }
        int hlo = i; if (kbase < 0 && hlo < 2) hlo = 2;
        int hhi = i + 4; { const int lim = (SEQ - 1 - kbase) >> 6; if (hhi > lim) hhi = lim; }
        bf16x8 kf[2 * NKS];
        { const LAS unsigned char* Kb0 = lds + hh * 8192 + (64 * hlo + r32) * 16;
#pragma unroll
          for (int ks = 0; ks < NKS; ++ks) { kf[2 * ks] = *(const LAS bf16x8*)(Kb0 + ks * 16384); kf[2 * ks + 1] = *(const LAS bf16x8*)(Kb0 + ks * 16384 + 512); } }
#pragma unroll 1
        for (int hf = hlo; hf <= hhi; ++hf) {
            const int kh0 = kbase + 64 * hf;
            const LAS unsigned char* Kb = lds + hh * 8192 + (64 * hf + r32) * 16;
            const LAS unsigned char* vb = lds + VOFFW + (4 * hf) * 1024 + vlane;
            s16x4 vl0[4], vh0[4], vl1[4], vh1[4];
#pragma unroll
            for (int j = 0; j < 4; ++j) { vl0[j] = vtr(vb + j * 1024); vh0[j] = vtr(vb + j * 1024 + 512); }
            __builtin_amdgcn_sched_barrier(0);
            f32x16 sa, sb;
#pragma unroll
            for (int ks = 0; ks < NKS; ++ks) {
                sa = __builtin_amdgcn_mfma_f32_32x32x16_bf16(kf[2 * ks], qf[ks], ks == 0 ? negm : sa, 0, 0, 0);
                sb = __builtin_amdgcn_mfma_f32_32x32x16_bf16(kf[2 * ks + 1], qf[ks], ks == 0 ? negm : sb, 0, 0, 0);
            }
#pragma unroll
            for (int j = 0; j < 4; ++j) { vl1[j] = vtr(vb + 32768 + j * 1024); vh1[j] = vtr(vb + 32768 + j * 1024 + 512); }
            if (hf < hhi) {
#pragma unroll
                for (int ks = 0; ks < NKS; ++ks) { kf[2 * ks] = *(const LAS bf16x8*)(Kb + 1024 + ks * 16384); kf[2 * ks + 1] = *(const LAS bf16x8*)(Kb + 1024 + ks * 16384 + 512); }
            }
            __builtin_amdgcn_sched_barrier(0);
            {
                const bool full = (kh0 >= qw0 - 97) && (kh0 + 63 <= qw0 + 128);
                const LAS unsigned char* pb = lds + POSW + (64 * hf + 4 * hh) * 4;
#pragma unroll
                for (int gq = 0; gq < 4; ++gq) {
                    const f32x4 kpa = *(const LAS f32x4*)(pb + (8 * gq) * 4), kpb = *(const LAS f32x4*)(pb + (32 + 8 * gq) * 4);
                    const int d0 = kh0 + 8 * gq + 4 * hh - qi + 128;
#pragma unroll
                    for (int e = 0; e < 4; ++e) { const int ii = 4 * gq + e;
                        const float va = fmaf(-slope2, fabsf(kpa[e] - qposf), sa[ii]), vb2 = fmaf(-slope2, fabsf(kpb[e] - qposf), sb[ii]);
                        sa[ii] = (full || (unsigned)(d0 + e) <= (unsigned)dmax) ? va : -1e30f;
                        sb[ii] = (full || (unsigned)(d0 + 32 + e) <= (unsigned)dmax) ? vb2 : -1e30f; }
                }
            }
            float rm = __builtin_fmaxf(sa[0], sb[0]);
#pragma unroll
            for (int e = 1; e < 16; ++e) rm = __builtin_fmaxf(__builtin_fmaxf(rm, sa[e]), sb[e]);
            rm = xhalf_max(rm);
            if (__any(rm > 8.f)) {
                const float dl = fmaxf(rm, 0.f); mref += dl; const float al = __builtin_amdgcn_exp2f(-dl); lrun *= al;
#pragma unroll
                for (int e = 0; e < 16; ++e) { negm[e] = -mref; o0[e] *= al; o1[e] *= al; sa[e] -= dl; sb[e] -= dl; }
                asm volatile("" : "+v"(negm));
            }
            float ps0 = 0.f, ps1 = 0.f;
#pragma unroll
            for (int e = 0; e < 16; ++e) { sa[e] = __builtin_amdgcn_exp2f(sa[e]); sb[e] = __builtin_amdgcn_exp2f(sb[e]); ps0 += sa[e]; ps1 += sb[e]; }
            lrun += ps0 + ps1;
            bf16x8 pk[4];
#pragma unroll
            for (int j = 0; j < 4; ++j) { u32x4 w; const int b = 8 * (j & 1);
                if (j < 2) { w.x = cvt_pk_bf16(sa[b], sa[b + 1]); w.y = cvt_pk_bf16(sa[b + 2], sa[b + 3]); w.z = cvt_pk_bf16(sa[b + 4], sa[b + 5]); w.w = cvt_pk_bf16(sa[b + 6], sa[b + 7]); }
                else { w.x = cvt_pk_bf16(sb[b], sb[b + 1]); w.y = cvt_pk_bf16(sb[b + 2], sb[b + 3]); w.z = cvt_pk_bf16(sb[b + 4], sb[b + 5]); w.w = cvt_pk_bf16(sb[b + 6], sb[b + 7]); }
                pk[j] = __builtin_bit_cast(bf16x8, w); }
#pragma unroll
            for (int j = 0; j < 4; ++j) {
                const bf16x8 v0 = (bf16x8){vl0[j][0], vl0[j][1], vl0[j][2], vl0[j][3], vh0[j][0], vh0[j][1], vh0[j][2], vh0[j][3]};
                o0 = __builtin_amdgcn_mfma_f32_32x32x16_bf16(v0, pk[j], o0, 0, 0, 0);
            }
#pragma unroll
            for (int j = 0; j < 4; ++j) {
                const bf16x8 v1 = (bf16x8){vl1[j][0], vl1[j][1], vl1[j][2], vl1[j][3], vh1[j][0], vh1[j][1], vh1[j][2], vh1[j][3]};
                o1 = __builtin_amdgcn_mfma_f32_32x32x16_bf16(v1, pk[j], o1, 0, 0, 0);
            }
        }
        const float inv = 1.f / xhalf_sum(lrun);
        bf16_t* orow = Op + (size_t)qi * ldo + (wid >> 1) * 64 + 8 * hh;
#pragma unroll
        for (int gp = 0; gp < 2; ++gp)
#pragma unroll
            for (int dh = 0; dh < 2; ++dh) {
                const int ga = 2 * gp, gb = 2 * gp + 1;
                unsigned ax, ay, bx2, by2;
                if (dh == 0) { ax = cvt_pk_bf16(o0[4 * ga] * inv, o0[4 * ga + 1] * inv); ay = cvt_pk_bf16(o0[4 * ga + 2] * inv, o0[4 * ga + 3] * inv); bx2 = cvt_pk_bf16(o0[4 * gb] * inv, o0[4 * gb + 1] * inv); by2 = cvt_pk_bf16(o0[4 * gb + 2] * inv, o0[4 * gb + 3] * inv); }
                else { ax = cvt_pk_bf16(o1[4 * ga] * inv, o1[4 * ga + 1] * inv); ay = cvt_pk_bf16(o1[4 * ga + 2] * inv, o1[4 * ga + 3] * inv); bx2 = cvt_pk_bf16(o1[4 * gb] * inv, o1[4 * gb + 1] * inv); by2 = cvt_pk_bf16(o1[4 * gb + 2] * inv, o1[4 * gb + 3] * inv); }
                const auto rx = __builtin_amdgcn_permlane32_swap(ax, bx2, false, false);
                const auto ry = __builtin_amdgcn_permlane32_swap(ay, by2, false, false);
                u32x4 w; w.x = rx[0]; w.y = ry[0]; w.z = rx[1]; w.w = ry[1];
                *(u32x4*)(orow + 32 * dh + 16 * gp) = w;
            }
    }
    AT_WAIT_L0(); AT_BAR();
}

__device__ __forceinline__ void tr_item64(const float* __restrict__ W, int N, int k0, int nsrc, const float* __restrict__ gs, bf16_t* WT, int ldk, int ndst, int lane) {
    const int rq = lane >> 4, kk = k0 + 16 * rq;
    f32x4 v[16];
    if (nsrc >= 0) {
#pragma unroll
        for (int i = 0; i < 16; ++i) v[i] = *(const f32x4*)(W + (size_t)(kk + i) * N + nsrc);
        if (gs) {
#pragma unroll
            for (int i4 = 0; i4 < 4; ++i4) { const f32x4 g4 = *(const f32x4*)(gs + kk + 4 * i4);
#pragma unroll
                for (int e = 0; e < 4; ++e) v[4 * i4 + e] = v[4 * i4 + e] * g4[e]; }
        }
    } else {
#pragma unroll
        for (int i = 0; i < 16; ++i) v[i] = (f32x4){0.f, 0.f, 0.f, 0.f};
    }
#pragma unroll
    for (int e = 0; e < 4; ++e) {
        u32x4 w0, w1;
        w0.x = cvt_pk_bf16(v[0][e], v[1][e]); w0.y = cvt_pk_bf16(v[2][e], v[3][e]); w0.z = cvt_pk_bf16(v[4][e], v[5][e]); w0.w = cvt_pk_bf16(v[6][e], v[7][e]);
        w1.x = cvt_pk_bf16(v[8][e], v[9][e]); w1.y = cvt_pk_bf16(v[10][e], v[11][e]); w1.z = cvt_pk_bf16(v[12][e], v[13][e]); w1.w = cvt_pk_bf16(v[14][e], v[15][e]);
        bf16_t* d = WT + (size_t)(ndst + e) * ldk + kk;
        *(u32x4*)d = w0; *(u32x4*)(d + 8) = w1;
    }
}

__device__ __constant__ double INV_FREQ[16] = {1.0, 0.5623413251903491, 0.31622776601683794, 0.1778279410038923, 0.1, 0.05623413251903491, 0.03162277660168379, 0.01778279410038923,
                                               0.01, 0.005623413251903491, 0.0031622776601683794, 0.0017782794100389228, 0.001, 0.0005623413251903491, 0.00031622776601683794, 0.00017782794100389227};
__device__ __forceinline__ void sincos_d(double x, float& sn, float& cs) {
    const double n = rint(x * 0.15915494309189535);
    double r = fma(-n, 6.283185307179586, x); r = fma(-n, 2.4492935982947064e-16, r);
    const double r2 = r * r; double s = 1.0, c = 1.0;
#pragma unroll
    for (int k = 12; k >= 1; --k) { s = 1.0 - r2 * (1.0 / (double)((2 * k) * (2 * k + 1))) * s; c = 1.0 - r2 * (1.0 / (double)((2 * k - 1) * (2 * k))) * c; }
    sn = (float)(r * s); cs = (float)c;
}


#define XB_TMO      128
#define XB_XCNT(j)  (256  + 64 * (j))
#define XB_XSUB(j)  (1280 + 64 * (j))
#define XB_XGEN(j)  (2304 + 64 * (j))
#define XB_TOP      3328
#define XB_TOPGEN   3392
#define XCD_BAR_WORDS 3456
#define XB_SPIN_CAP (1u << 18)
__device__ __forceinline__ unsigned xb_ld(unsigned* p)              { return __hip_atomic_load(p, __ATOMIC_RELAXED, __HIP_MEMORY_SCOPE_AGENT); }
__device__ __forceinline__ unsigned xb_add(unsigned* p, unsigned v) { return __hip_atomic_fetch_add(p, v, __ATOMIC_RELAXED, __HIP_MEMORY_SCOPE_AGENT); }
__device__ __forceinline__ unsigned xb_xcc_id() { return (unsigned)__builtin_amdgcn_s_getreg((3 << 11) | 20) & 0xFu; }
#define XB_SPIN(cond, bar) do { unsigned _sp = 0; while (cond) { __builtin_amdgcn_s_sleep(1); \
    if ((++_sp & 255u) == 0u) { if (xb_ld(&(bar)[XB_TMO])) break; if (_sp > XB_SPIN_CAP) { atomicAdd(&(bar)[XB_TMO], 1u); break; } } } } while (0)
struct XcdBarrier { unsigned* bar; unsigned x; volatile LAS unsigned* st; };
#define XB_T0(wave_s) ((wave_s) == 0 && __builtin_amdgcn_mbcnt_hi(~0u, __builtin_amdgcn_mbcnt_lo(~0u, 0u)) == 0u)
__device__ __forceinline__ XcdBarrier xcd_barrier_post(unsigned* bar, volatile LAS unsigned* st, const int wave_s) {
    XcdBarrier b; b.bar = bar; b.x = xb_xcc_id(); b.st = st;
    if (XB_T0(wave_s)) (void)xb_add(&bar[XB_XCNT(b.x)], 1u);
    return b;
}
__device__ __forceinline__ void xcd_barrier_complete(unsigned* bar, unsigned x, unsigned& nloc, unsigned& nx) {
    const unsigned G = gridDim.x * gridDim.y * gridDim.z;
    unsigned sum, cnt, mine, sp = 0u;
    for (;;) {
        sum = 0u; cnt = 0u; mine = 0u;
#pragma unroll
        for (unsigned j = 0; j < 16; ++j) { const unsigned c = xb_ld(&bar[XB_XCNT(j)]); sum += c; cnt += (c > 0u) ? 1u : 0u; mine = (j == x) ? c : mine; }
        if (sum == G) break;
        __builtin_amdgcn_s_sleep(1);
        if ((++sp & 255u) == 0u) { if (xb_ld(&bar[XB_TMO])) break; if (sp > XB_SPIN_CAP) { atomicAdd(&bar[XB_TMO], 1u); break; } }
    }
    nloc = mine > 0u ? mine : 1u; nx = cnt > 0u ? cnt : 1u;
}
__device__ __forceinline__ void xcd_local_barrier(const XcdBarrier& b, const int wave_s) {
    asm volatile("s_waitcnt vmcnt(0)" ::: "memory");
    __syncthreads();
    if (XB_T0(wave_s)) {
        unsigned* bar = b.bar;
        __builtin_amdgcn_s_waitcnt(0);
        const unsigned nloc = b.st[0];
        const unsigned old = xb_add(&bar[XB_XSUB(b.x)], 1u);
        const unsigned gen = old / nloc;
        if (old + 1u == (gen + 1u) * nloc) xb_add(&bar[XB_XGEN(b.x)], 1u);
        else XB_SPIN(xb_ld(&bar[XB_XGEN(b.x)]) == gen, bar);
        __builtin_amdgcn_fence(__ATOMIC_ACQUIRE, "agent");
        asm volatile("s_waitcnt vmcnt(0)" ::: "memory");
    }
    __syncthreads();
}
__device__ __forceinline__ void xcd_barrier(const XcdBarrier& b, const int wave_s) {
    asm volatile("s_waitcnt vmcnt(0)" ::: "memory");
    __syncthreads();
    if (XB_T0(wave_s)) {
        unsigned* bar = b.bar;
        __builtin_amdgcn_s_waitcnt(0);
        unsigned nloc = b.st[0], nx = b.st[1];
        if (nloc == 0u) { xcd_barrier_complete(bar, b.x, nloc, nx); b.st[0] = nloc; b.st[1] = nx; }
        const unsigned old = xb_add(&bar[XB_XSUB(b.x)], 1u);
        const unsigned gen = old / nloc;
        if (old + 1u == (gen + 1u) * nloc) {
            __builtin_amdgcn_fence(__ATOMIC_RELEASE, "agent");
            asm volatile("s_waitcnt vmcnt(0)" ::: "memory");
            const unsigned og = xb_add(&bar[XB_TOP], 1u);
            const unsigned tg = og / nx;
            if (og + 1u == (tg + 1u) * nx) xb_add(&bar[XB_TOPGEN], 1u);
            else XB_SPIN(xb_ld(&bar[XB_TOPGEN]) == tg, bar);
            __builtin_amdgcn_fence(__ATOMIC_ACQUIRE, "agent");
            xb_add(&bar[XB_XGEN(b.x)], 1u);
            asm volatile("s_waitcnt vmcnt(0)" ::: "memory");
        } else {
            XB_SPIN(xb_ld(&bar[XB_XGEN(b.x)]) == gen, bar);
            __builtin_amdgcn_fence(__ATOMIC_ACQUIRE, "agent");
            asm volatile("s_waitcnt vmcnt(0)" ::: "memory");
        }
    }
    __syncthreads();
}


__device__ __forceinline__ unsigned char* opq(unsigned char* p) { asm volatile("" : "+s"(p)); return p; }
#define P_HB(w) ((bf16_t*)((w) + WS_HB))
#define P_R0(w) ((bf16_t*)((w) + WS_R0))
#define P_KVM(w) ((bf16_t*)((w) + WS_KVM))
#define P_OB(w) ((bf16_t*)((w) + WS_O))
#define P_KR(w) ((bf16_t*)((w) + WS_KR))
#define P_LAT(w) ((bf16_t*)((w) + WS_LAT))
#define P_SSQH(w) ((float*)((w) + WS_SSQH))
#define P_SSQL(w) ((float*)((w) + WS_SSQL))
#define P_COS(w) ((float*)((w) + WS_COS))
#define P_SIN(w) ((float*)((w) + WS_SIN))
#define P_POSF(w) ((float*)((w) + WS_POSF))


#define CONVERT_LAYER(LY, PARTS, wk, nwk, lane_) do { \
    const int ly_ = (LY), j_ = ly_ >> 1, cg4_ = 4 * ((lane_) & 15); \
    constexpr int I0 = 384, I1 = 256, I2 = 192, I3 = 144, I4 = 128, I6 = 1408, I7 = 704; \
    const int nmix_ = (ly_ & 1) ? (I2 + I3 + I4 + I1) : (I0 + I1); \
    const int lo_ = ((PARTS) & 1) ? 0 : nmix_, hi_ = ((PARTS) & 2) ? nmix_ + I6 + I7 : nmix_; \
    for (int it_ = lo_ + (wk); it_ < hi_; it_ += (nwk)) { \
        int r = it_; \
        if (r >= nmix_) { r -= nmix_; \
            if (r < I6) { const int kb = r / 88, nd = (r % 88) * 64 + cg4_; const int ns = ((nd >> 7) & 1) * DFF + (nd >> 8) * 128 + (nd & 127); \
                tr_item64(ffn_w_gu + (size_t)ly_ * DM * GU, GU, kb * 64, ns, norm_ffn + ly_ * DM, (bf16_t*)(ws + WS_WGU + ly_ * SZ_WGU), DM, nd, (lane_)); } \
            else { r -= I6; const int kb = r / 16, nd = (r % 16) * 64 + cg4_; \
                tr_item64(ffn_w_down + (size_t)ly_ * DFF * DM, DM, kb * 64, nd, nullptr, (bf16_t*)(ws + WS_WDN + ly_ * SZ_WDN), DFF, nd, (lane_)); } \
        } else if ((ly_ & 1) == 0) { \
            if (r < I0) { const int kb = r / 24, nd = (r % 24) * 64 + cg4_; \
                tr_item64(a_w_qkv + (size_t)j_ * DM * AQKV, AQKV, kb * 64, nd, norm_mix + ly_ * DM, (bf16_t*)(ws + WS_WQKV + j_ * SZ_WQKV), DM, nd, (lane_)); } \
            else { r -= I0; const int kb = r / 16, nd = (r % 16) * 64 + cg4_; \
                tr_item64(a_w_o + (size_t)j_ * DM * DM, DM, kb * 64, nd, nullptr, (bf16_t*)(ws + WS_WOA + j_ * SZ_WO), DM, nd, (lane_)); } \
        } else { \
            if (r < I2) { const int kb = r / 12, nd = (r % 12) * 64 + cg4_; const int ns = nd < 256 ? 384 + nd : (nd < 640 ? nd - 256 : (nd < 672 ? nd : -1)); \
                tr_item64(b_w_in + (size_t)j_ * DM * BIN, BIN, kb * 64, ns, norm_mix + ly_ * DM, (bf16_t*)(ws + WS_WIN + j_ * SZ_WIN), DM, nd, (lane_)); } \
            else if (r < I2 + I3) { r -= I2; const int kb = r / 24, nd = (r % 24) * 64 + cg4_; \
                tr_item64(b_w_uq + (size_t)j_ * QL * UQ, UQ, kb * 64, nd, b_g_q + j_ * QL, (bf16_t*)(ws + WS_WUQ + j_ * SZ_WUQ), QL, nd, (lane_)); } \
            else if (r < I2 + I3 + I4) { r -= I2 + I3; const int kb = r / 32, nd = (r % 32) * 64 + cg4_; \
                tr_item64(b_w_ukv + (size_t)j_ * KVL * UKV, UKV, kb * 64, nd, b_g_kv + j_ * KVL, (bf16_t*)(ws + WS_WUKV + j_ * SZ_WUKV), KVL, nd, (lane_)); } \
            else { r -= I2 + I3 + I4; const int kb = r / 16, nd = (r % 16) * 64 + cg4_; \
                tr_item64(b_w_o + (size_t)j_ * DM * DM, DM, kb * 64, nd, nullptr, (bf16_t*)(ws + WS_WOB + j_ * SZ_WO), DM, nd, (lane_)); } \
        } \
    } } while (0)

struct Params { const float* in[16]; float* out; unsigned char* ws; };

__global__ void __launch_bounds__(512, 2) mk_fwd(Params P) {
    extern __shared__ __attribute__((aligned(16))) unsigned char lds_raw[];
    LAS unsigned char* lds = (LAS unsigned char*)lds_raw;
    cg::grid_group grid = cg::this_grid();
    const int wave_s = __builtin_amdgcn_readfirstlane((int)threadIdx.x >> 6);
    const int G = gridDim.x, bx = blockIdx.x;
    const int vcu = (G % 8 == 0) ? (bx % 8) * (G / 8) + bx / 8 : bx;
    unsigned char* ws = P.ws;
    const float* x = P.in[0]; const int* positions = (const int*)P.in[1];
    const float *norm_mix = P.in[2], *norm_ffn = P.in[3], *a_w_qkv = P.in[4], *a_sink = P.in[5], *a_w_o = P.in[6], *b_w_in = P.in[7], *b_g_q = P.in[8], *b_g_kv = P.in[9],
                *b_w_uq = P.in[10], *b_w_ukv = P.in[11], *b_w_o = P.in[12], *ffn_w_gu = P.in[13], *ffn_w_down = P.in[14], *final_norm = P.in[15];
    float* out = P.out;
    unsigned* barw = (unsigned*)ws;
    volatile LAS unsigned* xst = (volatile LAS unsigned*)(lds + 131072 + 512);
    { const int t0 = tid_from_wave(wave_s); if (t0 < 4) xst[t0] = 0u; }
    __syncthreads();
    bf16_t* hb = (bf16_t*)(ws + WS_HB); bf16_t* r0 = (bf16_t*)(ws + WS_R0); bf16_t* kvm = (bf16_t*)(ws + WS_KVM); bf16_t* ob = (bf16_t*)(ws + WS_O); bf16_t* latb = (bf16_t*)(ws + WS_O);
    bf16_t* krb = (bf16_t*)(ws + WS_KR); float* ssqh = (float*)(ws + WS_SSQH); float* ssql = (float*)(ws + WS_SSQL); float* cosT = (float*)(ws + WS_COS); float* sinT = (float*)(ws + WS_SIN); float* posf = (float*)(ws + WS_POSF);

    XcdBarrier xbar; xbar.bar = barw; xbar.st = xst; xbar.x = xb_xcc_id();
    if (XB_T0(wave_s)) {
        const unsigned rk = xb_add(&barw[XB_XCNT(xbar.x)], 1u);
        unsigned nloc, nx; xcd_barrier_complete(barw, xbar.x, nloc, nx);
        unsigned ok = (G % 8 == 0 && xbar.x < 8u) ? 1u : 0u;
#pragma unroll
        for (unsigned jx = 0; jx < 8; ++jx) if (xb_ld(&barw[XB_XCNT(jx)]) != (unsigned)(G / 8)) ok = 0u;
        xst[0] = nloc; xst[1] = nx; xst[2] = rk; xst[3] = ok;
    }
    __syncthreads();
    const int lmode = __builtin_amdgcn_readfirstlane((int)xst[3]);
    const int xrank = __builtin_amdgcn_readfirstlane((int)xst[2]);
    const int cid = lmode ? xrank * 8 + (int)xbar.x : bx;
    const int cidr = lmode ? (G / 8 - 1 - xrank) * 8 + (int)xbar.x : G - 1 - bx;
    const int vcu2 = lmode ? (int)xbar.x * (G / 8) + xrank : vcu;
    for (int rep = 0; rep < REP_PRO; ++rep) {
        const int tid = tid_from_wave(wave_s);
        const int lane = tid & 63, wave = __builtin_amdgcn_readfirstlane(tid >> 6);
        const int gw = vcu * 8 + wave, NGW = G * 8;
        CONVERT_LAYER(0, 1, gw, NGW, lane);
        for (int m = gw; m < T; m += NGW) {
            const f32x4* xr = (const f32x4*)(x + (size_t)m * DM) + lane; f32x4 v[4]; float s = 0.f;
#pragma unroll
            for (int j = 0; j < 4; ++j) { v[j] = xr[64 * j]; s += dot4(v[j]); }
            s = wave_sum(s);
            u32x2* o8 = (u32x2*)(hb + (size_t)m * DM) + lane;
#pragma unroll
            for (int j = 0; j < 4; ++j) { u32x2 w; w.x = cvt_pk_bf16(v[j][0], v[j][1]); w.y = cvt_pk_bf16(v[j][2], v[j][3]); o8[64 * j] = w; }
            if (lane < 16) ssqh[(size_t)m * 16 + lane] = (lane == 0) ? s : 0.f;
        }
        for (int idx = (vcu * 512 + tid); idx < T * 16; idx += G * 512) { const int t = idx >> 4, i = idx & 15; float sn, cs; sincos_d((double)positions[t] * INV_FREQ[i], sn, cs); cosT[idx] = cs; sinT[idx] = sn; if (i == 0) posf[t] = (float)positions[t]; }
    }
    if (gridDim.y > 1u) grid.sync();
    GSYNC();

#pragma unroll 1
    for (int layer = 0; layer < 4; ++layer) {
        const int j = layer >> 1;
        if ((layer & 1) == 0) {
            { unsigned char* wsl = opq(ws); pg8::Gemm g{P_HB(wsl), (const bf16_t*)(wsl + WS_WQKV + j * SZ_WQKV), T, AQKV, DM, DM}; pg8::StaticOrder S; S.init(T, AQKV, G, cid);
              EpiQkvA E{P_R0(wsl), P_KVM(wsl), P_KVM(wsl) + (size_t)T * 256, (RowScale{P_SSQH(wsl), 16, 0, 4, 1.f / 1024.f}), 0.125f * LOG2E};
              pg8::gemm_phase<EpiQkvA, pg8::StaticOrder, true>(lds, g, S, E, wave_s); }
            if (layer == 0) {
                const int busy = ((T / 256) * (AQKV / 256)) % G;
                const int tid = tid_from_wave(wave_s); const int lane = tid & 63, wave = __builtin_amdgcn_readfirstlane(tid >> 6);
                if (busy == 0) CONVERT_LAYER(0, 2, cid * 8 + wave, G * 8, lane);
                else if (cid >= busy) CONVERT_LAYER(0, 2, (cid - busy) * 8 + wave, (G - busy) * 8, lane);
            }
            GSYNC_L();
            if (G == 256) { unsigned char* wsl = opq(ws);
              const int b = vcu2 >> 5, kvh = (vcu2 >> 3) & 3, R0 = (vcu2 & 7) * 256; const size_t rb = (size_t)b * SEQ;
              attn_win_cu(lds, P_R0(wsl) + rb * AQKV + kvh * 256, AQKV, P_KVM(wsl) + (size_t)(b * 4 + kvh) * 8 * SEQ * 8, P_KVM(wsl) + (size_t)T * 256 + (size_t)(b * 4 + kvh) * 2 * SEQ * 32,
                          P_OB(wsl) + rb * DM + kvh * 256, DM, P_POSF(wsl) + rb, R0, kvh * 4, a_sink + j * 16, wave_s);
            } else
            for (int rep = 0; rep < REP_ATT; ++rep) { unsigned char* wsl = opq(ws); const int nper = (1024 + G - 1) / G;
              const int u0 = vcu2 * nper, u1 = ((vcu2 + 1) * nper < 1024) ? (vcu2 + 1) * nper : 1024; int ring = 0;
              for (int ui = u0; ui < u1; ++ui) {
                  const int b = ui >> 7, kvh = (ui >> 5) & 3, qb = ui & 31;
                  const int un = ui + 1, nb = un >> 7, nkvh = (un >> 5) & 3, nqb = un & 31;
                  const size_t rb = (size_t)b * SEQ;
                  attn_unit2<64, true>(lds, P_R0(wsl) + rb * AQKV + kvh * 256, AQKV, P_KVM(wsl) + (size_t)(b * 4 + kvh) * 8 * SEQ * 8, nullptr, P_KVM(wsl) + (size_t)T * 256 + (size_t)(b * 4 + kvh) * 2 * SEQ * 32,
                                      P_OB(wsl) + rb * DM + kvh * 256, DM, P_POSF(wsl) + rb, qb * 64, kvh * 4, a_sink + j * 16, wave_s,
                                      P_KVM(wsl) + (size_t)(nb * 4 + nkvh) * 8 * SEQ * 8, nullptr, P_KVM(wsl) + (size_t)T * 256 + (size_t)(nb * 4 + nkvh) * 2 * SEQ * 32, nqb * 64,
                                      (ui > u0 ? 1 : 0) | (un < u1 ? 2 : 0), ring);
              } }
            GSYNC_L();
        } else {
            { unsigned char* wsl = opq(ws); pg8::Gemm g{P_HB(wsl), (const bf16_t*)(wsl + WS_WIN + j * SZ_WIN), T, BINP, DM, DM}; pg8::StaticOrder S; S.init(T, BINP, G, cid);
              EpiLat E{P_LAT(wsl), P_SSQL(wsl), P_KR(wsl), P_COS(wsl), P_SIN(wsl), (RowScale{P_SSQH(wsl), 16, 0, 4, 1.f / 1024.f})};
              pg8::gemm_phase<EpiLat, pg8::StaticOrder, true>(lds, g, S, E, wave_s); }
            GSYNC_L();
            { unsigned char* wsl = opq(ws); pg8::Gemm g{P_LAT(wsl) + 256, (const bf16_t*)(wsl + WS_WUQ + j * SZ_WUQ), T, UQ, QL, BINP}; pg8::StaticOrder S; S.init(T, UQ, G, cid);
              EpiUq E{P_R0(wsl), P_COS(wsl), P_SIN(wsl), RowScale{P_SSQL(wsl), 24, 8, 3, 1.f / 384.f}, 0.10206207261596575f * LOG2E};
              pg8::gemm_phase<EpiUq, pg8::StaticOrder, true>(lds, g, S, E, wave_s); }
            { unsigned char* wsl = opq(ws); pg8::Gemm g{P_LAT(wsl), (const bf16_t*)(wsl + WS_WUKV + j * SZ_WUKV), T, UKV, KVL, BINP}; pg8::StaticOrder S; S.init(T, UKV, G, cidr);
              EpiKvB E{P_KVM(wsl), P_KVM(wsl) + (size_t)T * 1024, RowScale{P_SSQL(wsl), 24, 0, 2, 1.f / 256.f}};
              pg8::gemm_phase<EpiKvB, pg8::StaticOrder, true>(lds, g, S, E, wave_s); }
            GSYNC_L();
            for (int rep = 0; rep < REP_ATT; ++rep) { unsigned char* wsl = opq(ws); const int nper = (1024 + G - 1) / G;
              const int u0 = vcu2 * nper, u1 = ((vcu2 + 1) * nper < 1024) ? (vcu2 + 1) * nper : 1024; int ring = 0;
              for (int ui = u0; ui < u1; ++ui) {
                  int bh = ui >> 3, qb = ui & 7, nbh = (ui + 1) >> 3;
                  if (G == 256) { const int stepi = ui - u0; bh = (vcu2 >> 5) * 16 + ((vcu2 & 31) >> 3) + 4 * stepi; qb = vcu2 & 7; nbh = bh + 4; }
                  const int b = bh >> 4, h = bh & 15;
                  const int un = ui + 1, nb = nbh >> 4, nh = nbh & 15;
                  const size_t rb = (size_t)b * SEQ;
                  attn_unit2<96, false>(lds, P_R0(wsl) + rb * UQ + h * 96, UQ, P_KVM(wsl) + (size_t)(b * 16 + h) * 8 * SEQ * 8, P_KR(wsl) + (size_t)b * 4 * SEQ * 8, P_KVM(wsl) + (size_t)T * 1024 + (size_t)(b * 16 + h) * 2 * SEQ * 32,
                                       P_OB(wsl) + rb * DM + h * 64, DM, P_POSF(wsl) + rb, qb * 256, 0, nullptr, wave_s,
                                       P_KVM(wsl) + (size_t)(nb * 16 + nh) * 8 * SEQ * 8, P_KR(wsl) + (size_t)nb * 4 * SEQ * 8, P_KVM(wsl) + (size_t)T * 1024 + (size_t)(nb * 16 + nh) * 2 * SEQ * 32, (un & 7) * 256,
                                       (ui > u0 ? 1 : 0) | (un < u1 ? 2 : 0), ring);
              } }
            GSYNC_L();
        }
        { unsigned char* wsl = opq(ws); const bf16_t* wo = (layer & 1) ? (const bf16_t*)(wsl + WS_WOB + j * SZ_WO) : (const bf16_t*)(wsl + WS_WOA + j * SZ_WO);
          pg8::Gemm g{P_OB(wsl), wo, T, DM, DM, DM}; pg8::StaticOrder S; S.init(T, DM, G, cid);
          EpiResid E{P_HB(wsl), P_SSQH(wsl)};
          pg8::gemm_phase<EpiResid, pg8::StaticOrder, true>(lds, g, S, E, wave_s); }
        GSYNC();
        { unsigned char* wsl = opq(ws); pg8::Gemm g{P_HB(wsl), (const bf16_t*)(wsl + WS_WGU + layer * SZ_WGU), T, GU, DM, DM}; pg8::StaticOrder S; S.init(T, GU, G, cid);
          EpiSwiglu E{P_R0(wsl), (RowScale{P_SSQH(wsl), 16, 0, 4, 1.f / 1024.f})};
          pg8::gemm_phase<EpiSwiglu, pg8::StaticOrder, true>(lds, g, S, E, wave_s); }
        if (layer < 3) {
            const int busy = ((T / 256) * (GU / 256)) % G;
            const int tid = tid_from_wave(wave_s); const int lane = tid & 63, wave = __builtin_amdgcn_readfirstlane(tid >> 6);
            if (busy == 0) CONVERT_LAYER(layer + 1, 3, cid * 8 + wave, G * 8, lane);
            else if (cid >= busy) CONVERT_LAYER(layer + 1, 3, (cid - busy) * 8 + wave, (G - busy) * 8, lane);
        }
        GSYNC_L();
        { unsigned char* wsl = opq(ws); pg8::Gemm g{P_R0(wsl), (const bf16_t*)(wsl + WS_WDN + layer * SZ_WDN), T, DM, DFF, DFF}; pg8::StaticOrder S; S.init(T, DM, G, cid);
          EpiResid E{P_HB(wsl), P_SSQH(wsl)};
          pg8::gemm_phase<EpiResid, pg8::StaticOrder, true>(lds, g, S, E, wave_s); }
        GSYNC();
    }
    {
        const int tid = tid_from_wave(wave_s);
        const int lane = tid & 63, wave = __builtin_amdgcn_readfirstlane(tid >> 6);
        const int gw = vcu * 8 + wave, NGW = G * 8;
        for (int m = gw; m < T; m += NGW) {
            float s = (lane < 16) ? ssqh[(size_t)m * 16 + lane] : 0.f; s = wave_sum(s);
            const float rstd = rsqrtf(s * (1.f / 1024.f) + EPSN);
            const u32x2* hr = (const u32x2*)(hb + (size_t)m * DM) + lane; f32x4* xr = (f32x4*)(out + (size_t)m * DM) + lane; const f32x4* gr = (const f32x4*)final_norm + lane;
#pragma unroll
            for (int jj = 0; jj < 4; ++jj) { const u32x2 w = hr[64 * jj]; f32x4 v; v[0] = __uint_as_float(w.x << 16); v[1] = __uint_as_float(w.x & 0xffff0000u); v[2] = __uint_as_float(w.y << 16); v[3] = __uint_as_float(w.y & 0xffff0000u);
                xr[64 * jj] = v * rstd * gr[64 * jj]; }
        }
    }
}

extern "C" void kernel_launch(void* const* d_in, const int* in_sizes, int n_in, void* d_out, int out_size, void* d_ws, size_t ws_size, hipStream_t stream) {
    static int grid = 0;
    if (grid == 0) {
        if (n_in != 16 || out_size != T * DM || ws_size < WS_END) { fprintf(stderr, "kernel_launch: unexpected shapes (n_in %d out %d ws %zu need %zu)\n", n_in, out_size, ws_size, (size_t)WS_END); grid = -1; return; }
        int dev = 0, cus = 0, per_cu = 0;
        hipGetDevice(&dev); hipDeviceGetAttribute(&cus, hipDeviceAttributeMultiprocessorCount, dev);
        if (hipFuncSetAttribute((const void*)mk_fwd, hipFuncAttributeMaxDynamicSharedMemorySize, LDS_BYTES) != hipSuccess) { fprintf(stderr, "kernel_launch: hipFuncSetAttribute failed\n"); grid = -1; return; }
        if (hipOccupancyMaxActiveBlocksPerMultiprocessor(&per_cu, (const void*)mk_fwd, 512, LDS_BYTES) != hipSuccess || per_cu < 1) { fprintf(stderr, "kernel_launch: occupancy query says %d\n", per_cu); per_cu = 1; }
        (void)hipGetLastError();
        grid = cus;
    }
    if (grid < 0) return;
    if (hipMemsetAsync(d_ws, 0, 16384, stream) != hipSuccess) { fprintf(stderr, "kernel_launch: hipMemsetAsync of the barrier words failed\n"); return; }
    Params p{};
    for (int i = 0; i < 16; ++i) p.in[i] = (const float*)d_in[i];
    p.out = (float*)d_out; p.ws = (unsigned char*)d_ws;
    void* args[] = {&p};
    hipError_t e = hipLaunchCooperativeKernel((const void*)mk_fwd, dim3(grid), dim3(512), args, LDS_BYTES, stream);
    if (e != hipSuccess) fprintf(stderr, "cooperative launch failed: %s (grid %d)\n", hipGetErrorString(e), grid);
}
```

```cpp
#include <hip/hip_runtime.h>
#include <hip/hip_cooperative_groups.h>
#include <cstdio>
#include <cstdint>
namespace cg = cooperative_groups;

#define LAS __attribute__((address_space(3)))
typedef unsigned short bf16_t;
typedef short bf16x8 __attribute__((ext_vector_type(8)));
typedef short s16x4 __attribute__((ext_vector_type(4)));
typedef float f32x4 __attribute__((ext_vector_type(4)));
typedef float f32x16 __attribute__((ext_vector_type(16)));
typedef unsigned u32x4 __attribute__((ext_vector_type(4)));
typedef unsigned u32x2 __attribute__((ext_vector_type(2)));
typedef int i32x4 __attribute__((ext_vector_type(4)));

constexpr int NB = 8, SEQ = 2048, DM = 1024, T = NB * SEQ;
constexpr int AQKV = 1536, BIN = 672, BINP = 768, QL = 384, KVL = 256, UQ = 1536, UKV = 2048, DFF = 2816, GU = 2 * DFF;
constexpr float EPSN = 1e-6f;
constexpr float LOG2E = 1.4426950408889634f;

constexpr size_t MiB = 1u << 20;
constexpr size_t SZ_WQKV = (size_t)AQKV * DM * 2, SZ_WO = (size_t)DM * DM * 2, SZ_WIN = (size_t)BINP * DM * 2, SZ_WUQ = (size_t)UQ * QL * 2,
                 SZ_WUKV = (size_t)UKV * KVL * 2, SZ_WGU = (size_t)GU * DM * 2, SZ_WDN = (size_t)DM * DFF * 2;
constexpr size_t WS_WQKV = 1 * MiB;
constexpr size_t WS_WOA = WS_WQKV + 2 * SZ_WQKV;
constexpr size_t WS_WIN = WS_WOA + 2 * SZ_WO;
constexpr size_t WS_WUQ = WS_WIN + 2 * SZ_WIN;
constexpr size_t WS_WUKV = WS_WUQ + 2 * SZ_WUQ;
constexpr size_t WS_WOB = WS_WUKV + 2 * SZ_WUKV;
constexpr size_t WS_WGU = WS_WOB + 2 * SZ_WO;
constexpr size_t WS_WDN = WS_WGU + 4 * SZ_WGU;
constexpr size_t WS_WEND = WS_WDN + 4 * SZ_WDN;
constexpr size_t WS_HB = 90 * MiB;
constexpr size_t WS_R0 = 122 * MiB;
constexpr size_t WS_KVM = WS_R0 + 48 * MiB;
constexpr size_t WS_O = WS_KVM + 64 * MiB;
constexpr size_t WS_KR = WS_O + 32 * MiB;
constexpr size_t WS_SSQH = WS_KR + 1 * MiB;
constexpr size_t WS_SSQL = WS_SSQH + 1 * MiB;
constexpr size_t WS_COS = WS_SSQL + 2 * MiB;
constexpr size_t WS_SIN = WS_COS + 1 * MiB;
constexpr size_t WS_POSF = WS_SIN + 1 * MiB;
constexpr size_t WS_LAT = WS_POSF + 1 * MiB;
constexpr size_t WS_END = WS_LAT + 24 * MiB;
static_assert(WS_WEND <= WS_HB, "weights overflow");
static_assert((size_t)T * DFF * 2 <= 112 * MiB, "act overlay");

constexpr int LDS_BYTES = 147456;
#ifndef REP_SYNC
#define REP_SYNC 1
#endif
#ifndef REP_ATT
#define REP_ATT 1
#endif
#ifndef REP_PRO
#define REP_PRO 1
#endif
#define GSYNC() do { for (int _r = 0; _r < REP_SYNC; ++_r) xcd_barrier(xbar, wave_s); } while (0)
#define GSYNC_L() do { if (lmode) xcd_local_barrier(xbar, wave_s); else xcd_barrier(xbar, wave_s); } while (0)

__device__ __forceinline__ int tid_from_wave(int wave_s) { int t = wave_s * 64 + (int)__builtin_amdgcn_mbcnt_hi(~0u, __builtin_amdgcn_mbcnt_lo(~0u, 0u)); asm volatile("" : "+v"(t)); return t; }
typedef float f32x2_t __attribute__((ext_vector_type(2))); typedef __bf16 bf16x2_t __attribute__((ext_vector_type(2)));
__device__ __forceinline__ unsigned cvt_pk_bf16(float lo, float hi) { const f32x2_t v = {lo, hi}; const bf16x2_t b = __builtin_convertvector(v, bf16x2_t); return __builtin_bit_cast(unsigned, b); }
__device__ __forceinline__ float xhalf_max(float m) { auto rr = __builtin_amdgcn_permlane32_swap(__float_as_uint(m), __float_as_uint(m), false, false); return fmaxf(__uint_as_float(rr[0]), __uint_as_float(rr[1])); }
__device__ __forceinline__ float xhalf_sum(float m) { auto rr = __builtin_amdgcn_permlane32_swap(__float_as_uint(m), __float_as_uint(m), false, false); return __uint_as_float(rr[0]) + __uint_as_float(rr[1]); }
template <int K> __device__ __forceinline__ float xor_lane(float v) { return __int_as_float(__builtin_amdgcn_ds_swizzle(__float_as_int(v), (K << 10) | 0x1f)); }
__device__ __forceinline__ float wave_sum(float v) {
    v += xor_lane<1>(v); v += xor_lane<2>(v); v += xor_lane<4>(v); v += xor_lane<8>(v); v += xor_lane<16>(v);
    return xhalf_sum(v);
}

namespace pg8 {
constexpr int BM = 256, BK = 64, HALF = 128, HTB = HALF * BK * 2, STAGE_BYTES = 8 * HTB, NXCD = 8, WGM = 8;
__host__ __device__ __forceinline__ int lds_byte(int r, int c) { const int st = (r >> 4) * 2 + (c >> 5), rr = r & 15, cc = c & 31, ob = rr * 64 + cc * 2; return st * 1024 + (ob ^ (((ob >> 9) & 1) << 5)); }
__host__ __device__ __forceinline__ void stage_rc(int b, int& R, int& C) { const int st = b / 1024, sb = b % 1024, swz = sb ^ (((sb >> 9) & 1) << 5); R = (st >> 1) * 16 + swz / 64; C = (st & 1) * 32 + (swz % 64) / 2; }
__host__ __device__ __forceinline__ int perm32(int rho) { const int n = rho >> 4, i = rho & 15; return 8 * (i >> 2) + 4 * n + (i & 3); }
struct Unit { int pm, pn; };
struct Gemm { const bf16_t* A; const bf16_t* Bt; int M, N, K, lda; };
struct StaticOrder {
    int nM, nN, nwg, G, c;
    __device__ void init(int M, int N, int G_, int c_) { nM = M / BM; nN = N / BM; nwg = nM * nN; G = G_; c = c_; }
    __device__ bool next(int i, Unit& u) const {
        const long L = (long)i * G + c; if (L >= nwg) return false;
        int wgid = (int)L; { const int q = nwg / NXCD, r = nwg % NXCD, xcd = wgid % NXCD, off = wgid / NXCD; wgid = (xcd < r ? xcd * (q + 1) : r * (q + 1) + (xcd - r) * q) + off; }
        const int nig = WGM * nN, gid = wgid / nig, fm = gid * WGM, gsz = (nM - fm) < WGM ? (nM - fm) : WGM;
        u.pm = fm + ((wgid % nig) % gsz); u.pn = (wgid % nig) / gsz; return true;
    }
};

template <class Epi, class Sched, bool ALIGN_EPI>
__device__ __forceinline__ void gemm_phase(LAS unsigned char* lds, const Gemm g, const Sched& S, const Epi& E, const int wave_s) {
    const int tid = tid_from_wave(wave_s);
    const int wid = __builtin_amdgcn_readfirstlane(tid >> 6), lane = tid & 63, wr = wid >> 2, wc = wid & 3, fr = lane & 15, fq = lane >> 4;
    const int K = g.K, nt = K / BK, lda = g.lda;
    unsigned voffA[2], voffB[2];
#pragma unroll
    for (int i = 0; i < 2; ++i) { int R, C; stage_rc(tid * 16 + i * 8192, R, C); const int Rb = Epi::PERM ? ((R & ~31) + perm32(R & 31)) : R;
        voffA[i] = (unsigned)(R * lda + C) * 2u; voffB[i] = (unsigned)(Rb * K + C) * 2u; }
    const size_t kstep = (size_t)(BK * 2);
    const size_t hstepA = (size_t)HALF * lda * 2, hstepB = (size_t)HALF * K * 2;
    const size_t tstepA = 2 * hstepA, tstepB = 2 * hstepB;
    const unsigned ldsw = (unsigned)wid * 1024u;
    const int aoff = lds_byte(wr * 64 + fr, fq * 8), boff = lds_byte(wc * 32 + fr, fq * 8);
#define PG8_SA(b, h) (((b) * 2 + (h)) * HTB)
#define PG8_SB(b, h) ((4 + (b) * 2 + (h)) * HTB)
#define PG8_STAGE(bufoff, gbase, voff) do { _Pragma("unroll") for (int _i = 0; _i < 2; ++_i) \
        __builtin_amdgcn_global_load_lds((const unsigned*)((const char*)(gbase) + (voff)[_i]), (LAS unsigned*)(lds + (bufoff) + ldsw + _i * 8192), 16, 0, 0); } while (0)
#define PG8_LDA(dst, b, h) do { _Pragma("unroll") for (int m = 0; m < 4; ++m) _Pragma("unroll") for (int k = 0; k < 2; ++k) dst[m][k] = *(const LAS bf16x8*)(lds + PG8_SA(b, h) + aoff + m * 2048 + k * 1024); } while (0)
#define PG8_LDB(dst, b, h) do { _Pragma("unroll") for (int n = 0; n < 2; ++n) _Pragma("unroll") for (int k = 0; k < 2; ++k) dst[n][k] = *(const LAS bf16x8*)(lds + PG8_SB(b, h) + boff + n * 2048 + k * 1024); } while (0)
#define PG8_MMA(ai, bj, At, Bt) do { __builtin_amdgcn_s_setprio(1); _Pragma("unroll") for (int m = 0; m < 4; ++m) _Pragma("unroll") for (int n = 0; n < 2; ++n) _Pragma("unroll") for (int k = 0; k < 2; ++k) \
        acc[ai][bj][m][n] = __builtin_amdgcn_mfma_f32_16x16x32_bf16(Bt[n][k], At[m][k], acc[ai][bj][m][n], 0, 0, 0); __builtin_amdgcn_s_setprio(0); } while (0)
#define PG8_WAIT_V(n) asm volatile("s_waitcnt vmcnt(" #n ")" ::: "memory")
#define PG8_WAIT_L(n) asm volatile("s_waitcnt lgkmcnt(" #n ")" ::: "memory")
#define PG8_BAR __builtin_amdgcn_s_barrier()
#define PG8_SCHED __builtin_amdgcn_sched_barrier(0)
    Unit cur, nxt; int ui = 0;
    if (!S.next(0, cur)) return;
    f32x4 acc[2][2][4][2];
    if constexpr (Epi::ACC_INIT) E.init(acc, cur, wr, wc, fr, fq);
    else {
#pragma unroll
    for (int a = 0; a < 2; ++a)
#pragma unroll
        for (int b = 0; b < 2; ++b)
#pragma unroll
            for (int m = 0; m < 4; ++m)
#pragma unroll
                for (int n = 0; n < 2; ++n) acc[a][b][m][n] = (f32x4){0.f, 0.f, 0.f, 0.f};
    }
    bf16x8 At[4][2], B0[2][2], B1[2][2];
    const char* cA = (const char*)g.A + (size_t)cur.pm * tstepA; const char* cB = (const char*)g.Bt + (size_t)cur.pn * tstepB;
    PG8_STAGE(PG8_SB(0, 0), cB, voffB); PG8_STAGE(PG8_SB(0, 1), cB + hstepB, voffB); PG8_STAGE(PG8_SA(0, 0), cA, voffA); PG8_STAGE(PG8_SA(0, 1), cA + hstepA, voffA);
    if (wr == 1) PG8_BAR;
    PG8_WAIT_V(2); PG8_BAR;
    PG8_STAGE(PG8_SB(1, 0), cB + kstep, voffB); PG8_STAGE(PG8_SA(1, 0), cA + kstep, voffA); PG8_STAGE(PG8_SB(1, 1), cB + hstepB + kstep, voffB);
    PG8_WAIT_V(6); PG8_BAR;
    for (;;) {
        const bool has_next = S.next(ui + 1, nxt);
        const char* nA = has_next ? (const char*)g.A + (size_t)nxt.pm * tstepA : cA; const char* nB = has_next ? (const char*)g.Bt + (size_t)nxt.pn * tstepB : cB;
#pragma unroll 1
        for (int t = 0; t < nt; t += 2) {
            const bool last = (t == nt - 2);
            const char* a1 = cA + (size_t)(t + 1) * kstep;
            const char* a2 = last ? nA : cA + (size_t)(t + 2) * kstep; const char* b2 = last ? nB : cB + (size_t)(t + 2) * kstep;
            const char* a3 = a2 + kstep; const char* b3 = b2 + kstep;
            PG8_LDB(B0, 0, 0); PG8_LDB(B1, 0, 1); PG8_SCHED; PG8_LDA(At, 0, 0); PG8_STAGE(PG8_SA(1, 1), a1 + hstepA, voffA);
            PG8_WAIT_V(8); PG8_WAIT_L(0); PG8_BAR; PG8_MMA(0, 0, At, B0); PG8_MMA(0, 1, At, B1); PG8_BAR; PG8_SCHED;
            PG8_LDA(At, 0, 1); PG8_STAGE(PG8_SB(0, 0), b2, voffB); PG8_STAGE(PG8_SB(0, 1), b2 + hstepB, voffB); PG8_STAGE(PG8_SA(0, 0), a2, voffA);
            PG8_WAIT_V(8); PG8_WAIT_L(0); PG8_BAR; PG8_MMA(1, 0, At, B0); PG8_MMA(1, 1, At, B1); PG8_BAR; PG8_SCHED;
            PG8_LDB(B0, 1, 0); PG8_LDB(B1, 1, 1); PG8_SCHED; PG8_LDA(At, 1, 0); PG8_STAGE(PG8_SA(0, 1), a2 + hstepA, voffA);
            PG8_WAIT_V(8); PG8_WAIT_L(0); PG8_BAR; PG8_MMA(0, 0, At, B0); PG8_MMA(0, 1, At, B1); PG8_BAR; PG8_SCHED;
            PG8_LDA(At, 1, 1); PG8_STAGE(PG8_SB(1, 0), b3, voffB); PG8_STAGE(PG8_SB(1, 1), b3 + hstepB, voffB); PG8_STAGE(PG8_SA(1, 0), a3, voffA);
            PG8_WAIT_V(8); PG8_WAIT_L(0); PG8_BAR; PG8_MMA(1, 0, At, B0); PG8_MMA(1, 1, At, B1); PG8_BAR; PG8_SCHED;
        }
        if constexpr (ALIGN_EPI) { if (wr == 0) PG8_BAR; }
        { const int l2 = tid_from_wave(wave_s) & 63; E(acc, cur, wr, wc, l2 & 15, l2 >> 4); }
        if (!has_next) break;
        if constexpr (Epi::ACC_INIT) { const int l3 = tid_from_wave(wave_s) & 63; E.init(acc, nxt, wr, wc, l3 & 15, l3 >> 4); }
        else {
#pragma unroll
        for (int a = 0; a < 2; ++a)
#pragma unroll
            for (int b = 0; b < 2; ++b)
#pragma unroll
                for (int m = 0; m < 4; ++m)
#pragma unroll
                    for (int n = 0; n < 2; ++n) acc[a][b][m][n] = (f32x4){0.f, 0.f, 0.f, 0.f};
        }
        cur = nxt; cA = nA; cB = nB; ++ui;
        if constexpr (ALIGN_EPI) { if (wr == 1) PG8_BAR; }
    }
    PG8_WAIT_V(0);
    if constexpr (!ALIGN_EPI) { if (wr == 0) PG8_BAR; }
    PG8_BAR;
#undef PG8_SA
#undef PG8_SB
#undef PG8_STAGE
#undef PG8_LDA
#undef PG8_LDB
#undef PG8_MMA
#undef PG8_WAIT_V
#undef PG8_WAIT_L
#undef PG8_BAR
#undef PG8_SCHED
}
}

typedef f32x4 AccT[2][2][4][2];
struct RowScale { const float* ssq; int stride, off, n4; float inv_dim; };
__device__ __forceinline__ void load_rstd(float (&rs)[2][4], const RowScale& R, int row0, int fq) {
#pragma unroll
    for (int ai = 0; ai < 2; ++ai)
#pragma unroll
        for (int m = 0; m < 4; ++m) {
            const int row = row0 + ai * 128 + m * 16;
            f32x4 v = (f32x4){0.f, 0.f, 0.f, 0.f};
            if (fq < R.n4) v = *(const f32x4*)(R.ssq + (size_t)row * R.stride + R.off + 4 * fq);
            float s = (v[0] + v[1]) + (v[2] + v[3]);
            s += xor_lane<16>(s); s = xhalf_sum(s);
            rs[ai][m] = rsqrtf(s * R.inv_dim + EPSN);
        }
}
__device__ __forceinline__ float dot4(f32x4 v) { return (v[0] * v[0] + v[1] * v[1]) + (v[2] * v[2] + v[3] * v[3]); }

struct EpiBf16S {
    static constexpr bool PERM = true, ACC_INIT = false;
    bf16_t* O; int ldc; RowScale R; int scale_tiles; float scale0;
    __device__ __forceinline__ void operator()(const AccT& acc, const pg8::Unit& u, int wr, int wc, int fr, int fq) const {
        const int row0 = u.pm * 256 + wr * 64 + fr;
        float rs[2][4]; load_rstd(rs, R, row0, fq);
        const float sc = (u.pn < scale_tiles) ? scale0 : 1.f;
        const int col0 = u.pn * 256 + wc * 32 + 8 * fq;
#pragma unroll
        for (int ai = 0; ai < 2; ++ai)
#pragma unroll
            for (int m = 0; m < 4; ++m) { bf16_t* rowp = O + (size_t)(row0 + ai * 128 + m * 16) * ldc + col0; const float f = rs[ai][m] * sc;
#pragma unroll
                for (int bj = 0; bj < 2; ++bj) { const f32x4 v0 = acc[ai][bj][m][0] * f, v1 = acc[ai][bj][m][1] * f;
                    u32x4 w; w.x = cvt_pk_bf16(v0[0], v0[1]); w.y = cvt_pk_bf16(v0[2], v0[3]); w.z = cvt_pk_bf16(v1[0], v1[1]); w.w = cvt_pk_bf16(v1[2], v1[3]);
                    *(u32x4*)(rowp + bj * 128) = w; } }
    }
};

struct EpiQkvA {
    static constexpr bool PERM = true, ACC_INIT = false;
    bf16_t* Q; bf16_t* Kc; bf16_t* Vc; RowScale R; float scale0;
    __device__ __forceinline__ void operator()(const AccT& acc, const pg8::Unit& u, int wr, int wc, int fr, int fq) const {
        const int row0 = u.pm * 256 + wr * 64 + fr;
        float rs[2][4]; load_rstd(rs, R, row0, fq);
        const float sc = (u.pn < 4) ? scale0 : 1.f;
#pragma unroll
        for (int ai = 0; ai < 2; ++ai)
#pragma unroll
            for (int m = 0; m < 4; ++m) { const int row = row0 + ai * 128 + m * 16; const int b = row >> 11, key = row & 2047; const float f = rs[ai][m] * sc;
#pragma unroll
                for (int bj = 0; bj < 2; ++bj) { const f32x4 v0 = acc[ai][bj][m][0] * f, v1 = acc[ai][bj][m][1] * f;
                    u32x4 w; w.x = cvt_pk_bf16(v0[0], v0[1]); w.y = cvt_pk_bf16(v0[2], v0[3]); w.z = cvt_pk_bf16(v1[0], v1[1]); w.w = cvt_pk_bf16(v1[2], v1[3]);
                    const int cc = bj * 128 + wc * 32 + 8 * fq, kvh = cc >> 6, e6 = cc & 63;
                    bf16_t* dst;
                    if (u.pn < 4) dst = Q + (size_t)row * AQKV + u.pn * 256 + cc;
                    else if (u.pn == 4) dst = Kc + ((size_t)((b * 4 + kvh) * 8 + (e6 >> 3)) * SEQ + key) * 8;
                    else dst = Vc + ((size_t)((b * 4 + kvh) * 2 + (e6 >> 5)) * SEQ + key) * 32 + (e6 & 31);
                    *(u32x4*)dst = w; } }
    }
};
struct EpiKvB {
    static constexpr bool PERM = true, ACC_INIT = false;
    bf16_t* Kc; bf16_t* Vc; RowScale R;
    __device__ __forceinline__ void operator()(const AccT& acc, const pg8::Unit& u, int wr, int wc, int fr, int fq) const {
        const int row0 = u.pm * 256 + wr * 64 + fr;
        float rs[2][4]; load_rstd(rs, R, row0, fq);
        const int cc = wc * 32 + 8 * fq;
#pragma unroll
        for (int ai = 0; ai < 2; ++ai)
#pragma unroll
            for (int m = 0; m < 4; ++m) { const int row = row0 + ai * 128 + m * 16; const int b = row >> 11, key = row & 2047; const float f = rs[ai][m];
#pragma unroll
                for (int bj = 0; bj < 2; ++bj) { const f32x4 v0 = acc[ai][bj][m][0] * f, v1 = acc[ai][bj][m][1] * f;
                    u32x4 w; w.x = cvt_pk_bf16(v0[0], v0[1]); w.y = cvt_pk_bf16(v0[2], v0[3]); w.z = cvt_pk_bf16(v1[0], v1[1]); w.w = cvt_pk_bf16(v1[2], v1[3]);
                    const int h = u.pn * 2 + bj;
                    bf16_t* dst;
                    if (wc < 2) dst = Kc + ((size_t)((b * 16 + h) * 8 + (cc >> 3)) * SEQ + key) * 8;
                    else dst = Vc + ((size_t)((b * 16 + h) * 2 + ((cc - 64) >> 5)) * SEQ + key) * 32 + ((cc - 64) & 31);
                    *(u32x4*)dst = w; } }
    }
};
__device__ __forceinline__ float silu_mul(float g, float u) { return g * __builtin_amdgcn_rcpf(1.f + __expf(-g)) * u; }
struct EpiSwiglu {
    static constexpr bool PERM = true, ACC_INIT = false;
    bf16_t* O; RowScale R;
    __device__ __forceinline__ void operator()(const AccT& acc, const pg8::Unit& u, int wr, int wc, int fr, int fq) const {
        const int row0 = u.pm * 256 + wr * 64 + fr;
        float rs[2][4]; load_rstd(rs, R, row0, fq);
        const int col0 = u.pn * 128 + wc * 32 + 8 * fq;
#pragma unroll
        for (int ai = 0; ai < 2; ++ai)
#pragma unroll
            for (int m = 0; m < 4; ++m) { bf16_t* rowp = O + (size_t)(row0 + ai * 128 + m * 16) * DFF + col0; const float f = rs[ai][m];
                const float c1 = -f * LOG2E, f2 = f * f;
                const f32x4 g0 = acc[ai][0][m][0], g1 = acc[ai][0][m][1], u0 = acc[ai][1][m][0], u1 = acc[ai][1][m][1];
#define SG_(g, u) (((g) * (u)) * (f2 * __builtin_amdgcn_rcpf(1.f + __builtin_amdgcn_exp2f((g) * c1))))
                u32x4 w; w.x = cvt_pk_bf16(SG_(g0[0], u0[0]), SG_(g0[1], u0[1])); w.y = cvt_pk_bf16(SG_(g0[2], u0[2]), SG_(g0[3], u0[3]));
                w.z = cvt_pk_bf16(SG_(g1[0], u1[0]), SG_(g1[1], u1[1])); w.w = cvt_pk_bf16(SG_(g1[2], u1[2]), SG_(g1[3], u1[3]));
#undef SG_
                *(u32x4*)rowp = w; }
    }
};
struct EpiResid {
    static constexpr bool PERM = true, ACC_INIT = true;
    bf16_t* hb; float* ssq;
    __device__ __forceinline__ void init(AccT& acc, const pg8::Unit& u, int wr, int wc, int fr, int fq) const {
        const int row0 = u.pm * 256 + wr * 64 + fr; const int col0 = u.pn * 256 + wc * 32 + 8 * fq;
#pragma unroll
        for (int ai = 0; ai < 2; ++ai)
#pragma unroll
            for (int m = 0; m < 4; ++m) { const bf16_t* rp = hb + (size_t)(row0 + ai * 128 + m * 16) * DM + col0;
#pragma unroll
                for (int bj = 0; bj < 2; ++bj) { const u32x4 o = *(const u32x4*)(rp + bj * 128);
                    acc[ai][bj][m][0] = (f32x4){__uint_as_float(o.x << 16), __uint_as_float(o.x & 0xffff0000u), __uint_as_float(o.y << 16), __uint_as_float(o.y & 0xffff0000u)};
                    acc[ai][bj][m][1] = (f32x4){__uint_as_float(o.z << 16), __uint_as_float(o.z & 0xffff0000u), __uint_as_float(o.w << 16), __uint_as_float(o.w & 0xffff0000u)}; } }
    }
    __device__ __forceinline__ void operator()(const AccT& acc, const pg8::Unit& u, int wr, int wc, int fr, int fq) const {
        const int row0 = u.pm * 256 + wr * 64 + fr; const int col0 = u.pn * 256 + wc * 32 + 8 * fq;
#pragma unroll
        for (int ai = 0; ai < 2; ++ai)
#pragma unroll
            for (int m = 0; m < 4; ++m) { const int row = row0 + ai * 128 + m * 16; bf16_t* rp = hb + (size_t)row * DM + col0; float ss = 0.f;
#pragma unroll
                for (int bj = 0; bj < 2; ++bj) { const f32x4 v0 = acc[ai][bj][m][0], v1 = acc[ai][bj][m][1];
                    ss += dot4(v0) + dot4(v1);
                    u32x4 w; w.x = cvt_pk_bf16(v0[0], v0[1]); w.y = cvt_pk_bf16(v0[2], v0[3]); w.z = cvt_pk_bf16(v1[0], v1[1]); w.w = cvt_pk_bf16(v1[2], v1[3]);
                    *(u32x4*)(rp + bj * 128) = w; }
                ss += xor_lane<16>(ss); ss = xhalf_sum(ss);
                if (fq == 0) ssq[(size_t)row * 16 + u.pn * 4 + wc] = ss; }
    }
};
struct EpiLat {
    static constexpr bool PERM = false, ACC_INIT = false;
    bf16_t* lat; float* ssql; bf16_t* kr; const float* cosT; const float* sinT; RowScale R;
    __device__ __forceinline__ void operator()(const AccT& acc, const pg8::Unit& u, int wr, int wc, int fr, int fq) const {
        const int row0 = u.pm * 256 + wr * 64 + fr; const int col0 = u.pn * 256 + wc * 32 + 4 * fq;
        float rs[2][4]; load_rstd(rs, R, row0, fq);
#pragma unroll
        for (int ai = 0; ai < 2; ++ai)
#pragma unroll
            for (int m = 0; m < 4; ++m) { const int row = row0 + ai * 128 + m * 16; const float f = rs[ai][m];
#pragma unroll
                for (int bj = 0; bj < 2; ++bj) { float ss = 0.f;
#pragma unroll
                    for (int n = 0; n < 2; ++n) { const f32x4 v = acc[ai][bj][m][n] * f; ss += dot4(v); u32x2 w; w.x = cvt_pk_bf16(v[0], v[1]); w.y = cvt_pk_bf16(v[2], v[3]);
                        *(u32x2*)(lat + (size_t)row * BINP + col0 + bj * 128 + n * 16) = w; }
                    ss += xor_lane<16>(ss); ss = xhalf_sum(ss);
                    if (fq == 0) ssql[(size_t)row * 24 + u.pn * 8 + bj * 4 + wc] = ss; }
                if (u.pn == 2 && wc == 0) { const f32x4 t1 = acc[ai][1][m][0] * f, t2 = acc[ai][1][m][1] * f;
                    const f32x4 c = *(const f32x4*)(cosT + (size_t)row * 16 + 4 * fq), s = *(const f32x4*)(sinT + (size_t)row * 16 + 4 * fq);
                    const f32x4 o1 = t1 * c - t2 * s, o2 = t1 * s + t2 * c; u32x2 w1, w2; w1.x = cvt_pk_bf16(o1[0], o1[1]); w1.y = cvt_pk_bf16(o1[2], o1[3]); w2.x = cvt_pk_bf16(o2[0], o2[1]); w2.y = cvt_pk_bf16(o2[2], o2[3]);
                    const int b = row >> 11, key = row & 2047; bf16_t* kd = kr + ((size_t)(b * 4 + (fq >> 1)) * SEQ + key) * 8 + 4 * (fq & 1); *(u32x2*)kd = w1; *(u32x2*)(kd + (size_t)2 * SEQ * 8) = w2; } }
    }
};
struct EpiUq {
    static constexpr bool PERM = false, ACC_INIT = false;
    bf16_t* qm; const float* cosT; const float* sinT; RowScale R; float qscale;
    __device__ __forceinline__ void operator()(const AccT& acc, const pg8::Unit& u, int wr, int wc, int fr, int fq) const {
        const int row0 = u.pm * 256 + wr * 64 + fr; const int col0 = u.pn * 256 + wc * 32 + 4 * fq;
        float rs[2][4]; load_rstd(rs, R, row0, fq);
        const int G0 = u.pn * 8 + wc; const bool rp0 = (G0 % 3) == 2, rp1 = ((G0 + 4) % 3) == 2;
#pragma unroll
        for (int ai = 0; ai < 2; ++ai)
#pragma unroll
            for (int m = 0; m < 4; ++m) { const int row = row0 + ai * 128 + m * 16; const float f = rs[ai][m] * qscale;
                f32x4 c = (f32x4){1.f, 1.f, 1.f, 1.f}, s = (f32x4){0.f, 0.f, 0.f, 0.f};
                if (rp0 || rp1) { c = *(const f32x4*)(cosT + (size_t)row * 16 + 4 * fq); s = *(const f32x4*)(sinT + (size_t)row * 16 + 4 * fq); }
#pragma unroll
                for (int bj = 0; bj < 2; ++bj) { f32x4 v0 = acc[ai][bj][m][0] * f, v1 = acc[ai][bj][m][1] * f;
                    if (bj == 0 ? rp0 : rp1) { const f32x4 a = v0 * c - v1 * s, b = v0 * s + v1 * c; v0 = a; v1 = b; }
                    u32x2 w0, w1; w0.x = cvt_pk_bf16(v0[0], v0[1]); w0.y = cvt_pk_bf16(v0[2], v0[3]); w1.x = cvt_pk_bf16(v1[0], v1[1]); w1.y = cvt_pk_bf16(v1[2], v1[3]);
                    bf16_t* p = qm + (size_t)row * UQ + col0 + bj * 128; *(u32x2*)p = w0; *(u32x2*)(p + 16) = w1; } }
    }
};

__device__ __forceinline__ s16x4 vtr(const LAS unsigned char* p) { typedef short v4i16_t __attribute__((ext_vector_type(4))); return __builtin_bit_cast(s16x4, __builtin_amdgcn_ds_read_tr16_b64_v4i16((LAS v4i16_t*)p)); }

template <int DQK, bool WIN>
__device__ __forceinline__ void attn_unit(LAS unsigned char* lds, const bf16_t* __restrict__ Qp, int ldq, const bf16_t* __restrict__ Kp, int ldk, const bf16_t* __restrict__ KRp,
                                          const bf16_t* __restrict__ Vp, int ldv, bf16_t* Op, int ldo, const int* __restrict__ posb, int q0, float slope2, float sink2, const int wave_s) {
    constexpr int KS = DQK * 2 + 16, KBYTES = 64 * KS, VOFF = 2 * KBYTES, VBYTES = 8192, NKS = DQK / 16;
    const int tid = tid_from_wave(wave_s);
    const int lane = tid & 63, r32 = lane & 31, hh = lane >> 5;
    const int wid = __builtin_amdgcn_readfirstlane(tid >> 6);
    const int qw0 = q0 + wid * 32;
    int kbeg = 0, kend = SEQ;
    if (WIN) { kbeg = q0 - 128 < 0 ? 0 : q0 - 128; kend = q0 + 384 > SEQ ? SEQ : q0 + 384; }
    const int NT = (kend - kbeg) >> 6;
    bf16x8 qf[NKS];
#pragma unroll
    for (int ks = 0; ks < NKS; ++ks) qf[ks] = *(const bf16x8*)(Qp + (size_t)(qw0 + r32) * ldq + ks * 16 + hh * 8);
    const int skey = tid >> 3, sc8 = tid & 7;
    const bf16_t* kg = Kp + (size_t)(kbeg + skey) * ldk + sc8 * 8;
    const bf16_t* vg = Vp + (size_t)(kbeg + skey) * ldv + sc8 * 8;
    const int kl = skey * KS + sc8 * 16;
    const int vl = VOFF + ((skey >> 3) * 2 + (sc8 >> 2)) * 512 + (skey & 7) * 64 + (sc8 & 3) * 16;
    const bf16_t* krg = KRp + (size_t)(kbeg + (tid >> 2)) * 32 + (tid & 3) * 8;
    const int krl = (tid >> 2) * KS + 128 + (tid & 3) * 16;
    const bool has_kr = (DQK == 96) && (tid < 256);
    u32x4 kreg, vreg, krreg = (u32x4){0u, 0u, 0u, 0u};
    kreg = *(const u32x4*)kg; vreg = *(const u32x4*)vg; if (has_kr) krreg = *(const u32x4*)krg;
    *(LAS u32x4*)(lds + kl) = kreg; *(LAS u32x4*)(lds + vl) = vreg; if (has_kr) *(LAS u32x4*)(lds + krl) = krreg;
    __syncthreads();
    float mrun = WIN ? sink2 : -1e30f, lrun = (WIN && hh == 0) ? 1.f : 0.f;
    f32x16 o0, o1;
#pragma unroll
    for (int i = 0; i < 16; ++i) { o0[i] = 0.f; o1[i] = 0.f; }
    const int qi = qw0 + r32; int qpos = 0; if (WIN) qpos = posb[qi];
    const int vlane = (4 * hh + ((lane & 15) >> 2)) * 64 + ((lane >> 4) & 1) * 32 + (lane & 3) * 8;
    for (int t = 0; t < NT; ++t) {
        const int buf = t & 1;
        if (t + 1 < NT) { kreg = *(const u32x4*)(kg + (size_t)(t + 1) * 64 * ldk); vreg = *(const u32x4*)(vg + (size_t)(t + 1) * 64 * ldv); if (has_kr) krreg = *(const u32x4*)(krg + (size_t)(t + 1) * 64 * 32); }
        const int k0 = kbeg + 64 * t;
        const bool active = !WIN || (k0 + 63 >= qw0 - 128 && k0 <= qw0 + 31 + 128);
        if (active) {
            const LAS unsigned char* Kb = lds + buf * KBYTES + r32 * KS + hh * 16;
            f32x16 s0, s1;
#pragma unroll
            for (int i = 0; i < 16; ++i) { s0[i] = 0.f; s1[i] = 0.f; }
#pragma unroll
            for (int ks = 0; ks < NKS; ++ks) {
                const bf16x8 a0 = *(const LAS bf16x8*)(Kb + ks * 32);
                const bf16x8 a1 = *(const LAS bf16x8*)(Kb + 32 * KS + ks * 32);
                s0 = __builtin_amdgcn_mfma_f32_32x32x16_bf16(a0, qf[ks], s0, 0, 0, 0);
                s1 = __builtin_amdgcn_mfma_f32_32x32x16_bf16(a1, qf[ks], s1, 0, 0, 0);
            }
            if (WIN) {
#pragma unroll
                for (int gq = 0; gq < 4; ++gq) {
                    const int kb0 = k0 + 8 * gq + 4 * hh;
                    const i32x4 kp0 = *(const i32x4*)(posb + kb0), kp1 = *(const i32x4*)(posb + kb0 + 32);
#pragma unroll
                    for (int e = 0; e < 4; ++e) { const int i = 4 * gq + e; const int d0 = kb0 + e - qi, d1 = d0 + 32;
                        const int p0 = kp0[e] - qpos, p1 = kp1[e] - qpos;
                        const float f0 = (float)(p0 < 0 ? -p0 : p0), f1 = (float)(p1 < 0 ? -p1 : p1);
                        s0[i] = (d0 >= -128 && d0 <= 128) ? (s0[i] - slope2 * f0) : -1e30f;
                        s1[i] = (d1 >= -128 && d1 <= 128) ? (s1[i] - slope2 * f1) : -1e30f; }
                }
            }
            float mx = fmaxf(s0[0], s1[0]);
#pragma unroll
            for (int i = 1; i < 16; ++i) mx = fmaxf(mx, fmaxf(s0[i], s1[i]));
            mx = xhalf_max(mx);
            const float mnew = fmaxf(mrun, mx);
            const float alpha = __builtin_amdgcn_exp2f(mrun - mnew);
            mrun = mnew;
            float ps = 0.f;
#pragma unroll
            for (int i = 0; i < 16; ++i) { s0[i] = __builtin_amdgcn_exp2f(s0[i] - mnew); s1[i] = __builtin_amdgcn_exp2f(s1[i] - mnew); ps += s0[i] + s1[i]; }
            lrun = lrun * alpha + ps;
#pragma unroll
            for (int i = 0; i < 16; ++i) { o0[i] *= alpha; o1[i] *= alpha; }
            bf16x8 pk[4];
#pragma unroll
            for (int s = 0; s < 4; ++s) { u32x4 w;
                if (s < 2) { const int b = 8 * s; w.x = cvt_pk_bf16(s0[b], s0[b + 1]); w.y = cvt_pk_bf16(s0[b + 2], s0[b + 3]); w.z = cvt_pk_bf16(s0[b + 4], s0[b + 5]); w.w = cvt_pk_bf16(s0[b + 6], s0[b + 7]); }
                else { const int b = 8 * (s - 2); w.x = cvt_pk_bf16(s1[b], s1[b + 1]); w.y = cvt_pk_bf16(s1[b + 2], s1[b + 3]); w.z = cvt_pk_bf16(s1[b + 4], s1[b + 5]); w.w = cvt_pk_bf16(s1[b + 6], s1[b + 7]); }
                pk[s] = __builtin_bit_cast(bf16x8, w); }
            const LAS unsigned char* vb = lds + VOFF + buf * VBYTES + vlane;
#pragma unroll
            for (int s = 0; s < 4; ++s) {
                const s16x4 l0 = vtr(vb + (4 * s + 0) * 512), h0 = vtr(vb + (4 * s + 2) * 512);
                const s16x4 l1 = vtr(vb + (4 * s + 1) * 512), h1 = vtr(vb + (4 * s + 3) * 512);
                const bf16x8 v0 = (bf16x8){l0[0], l0[1], l0[2], l0[3], h0[0], h0[1], h0[2], h0[3]};
                const bf16x8 v1 = (bf16x8){l1[0], l1[1], l1[2], l1[3], h1[0], h1[1], h1[2], h1[3]};
                o0 = __builtin_amdgcn_mfma_f32_32x32x16_bf16(v0, pk[s], o0, 0, 0, 0);
                o1 = __builtin_amdgcn_mfma_f32_32x32x16_bf16(v1, pk[s], o1, 0, 0, 0);
            }
        }
        if (t + 1 < NT) { const int nb = buf ^ 1; *(LAS u32x4*)(lds + nb * KBYTES + kl) = kreg; *(LAS u32x4*)(lds + nb * VBYTES + vl) = vreg; if (has_kr) *(LAS u32x4*)(lds + nb * KBYTES + krl) = krreg; }
        __syncthreads();
    }
    const float inv = 1.f / xhalf_sum(lrun);
    bf16_t* orow = Op + (size_t)qi * ldo + 4 * hh;
#pragma unroll
    for (int gq = 0; gq < 4; ++gq) {
        u32x2 w0, w1;
        w0.x = cvt_pk_bf16(o0[4 * gq] * inv, o0[4 * gq + 1] * inv); w0.y = cvt_pk_bf16(o0[4 * gq + 2] * inv, o0[4 * gq + 3] * inv);
        w1.x = cvt_pk_bf16(o1[4 * gq] * inv, o1[4 * gq + 1] * inv); w1.y = cvt_pk_bf16(o1[4 * gq + 2] * inv, o1[4 * gq + 3] * inv);
        *(u32x2*)(orow + 8 * gq) = w0; *(u32x2*)(orow + 32 + 8 * gq) = w1;
    }
}


#define AT_WAIT_V(n) asm volatile("s_waitcnt vmcnt(" #n ")" ::: "memory")
#define AT_WAIT_L0() asm volatile("s_waitcnt lgkmcnt(0)" ::: "memory")
#define AT_BAR() do { __builtin_amdgcn_s_barrier(); asm volatile("" ::: "memory"); } while (0)
#define AT_DMA(gp, lp) __builtin_amdgcn_global_load_lds((const unsigned*)(gp), (LAS unsigned*)(lp), 16, 0, 0)
template <int DQK, bool WIN>
__device__ __forceinline__ void attn_unit2(LAS unsigned char* lds, const bf16_t* __restrict__ Qp, int ldq, const bf16_t* __restrict__ Kc, const bf16_t* __restrict__ KRc,
                                           const bf16_t* __restrict__ Vc, bf16_t* Op, int ldo, const float* __restrict__ posfb, int q0, int hbase, const float* __restrict__ sinkp, const int wave_s,
                                           const bf16_t* __restrict__ nKc, const bf16_t* __restrict__ nKRc, const bf16_t* __restrict__ nVc, int nq0, int flags, int& so_io) {
    constexpr int NCH = DQK / 8, KB = NCH * 2048, SB = KB + 16384, POSOFF = 3 * SB, NKS = DQK / 16;
    static_assert(POSOFF + 2048 <= 131072, "attention LDS");
    const int tid = tid_from_wave(wave_s);
    const int lane = tid & 63, r32 = lane & 31, hh = lane >> 5;
    const int wid = __builtin_amdgcn_readfirstlane(tid >> 6);
    const int qw0 = WIN ? q0 + (wid & 1) * 32 : q0 + wid * 32, qi = qw0 + r32;
    int kbeg = 0, kend = SEQ;
    if (WIN) { kbeg = q0 - 128 < 0 ? 0 : q0 - 128; kend = q0 + 192 > SEQ ? SEQ : q0 + 192; Qp += (wid >> 1) * 64; Op += (wid >> 1) * 64; }
    const int NT = (kend - kbeg + 127) >> 7;
    float slope2 = 0.f, sink2 = 0.f;
    if (WIN) { const int h = hbase + (wid >> 1); slope2 = exp2f(-0.5f * (float)(h + 1)) * LOG2E; sink2 = sinkp[h] * LOG2E; }
    const int dmax = (SEQ - 1 - qi + 128) < 256 ? (SEQ - 1 - qi + 128) : 256;
    int nkbeg = 0, nNT = SEQ >> 7;
    if (WIN) { nkbeg = nq0 - 128 < 0 ? 0 : nq0 - 128; const int nkend = nq0 + 192 > SEQ ? SEQ : nq0 + 192; nNT = (nkend - nkbeg + 127) >> 7; }
    LAS unsigned char* kdst = lds + wid * 2048;
    LAS unsigned char* krdst = lds + (8 + (wid >> 1)) * 2048 + (wid & 1) * 1024;
    LAS unsigned char* vdst = lds + KB + wid * 1024;
#define AT_STAGE_U(KC, KRC, VC, KBEG, t, so) do { const int _k0 = (KBEG) + (t) * 128; \
        if (WIN) {   \
            const int _ka = _k0 + lane, _kb = _ka + 64, _kv = _k0 + 16 * wid + (lane >> 2); \
            const bf16_t* _k = (KC) + (size_t)wid * SEQ * 8; const bf16_t* _v = (VC) + (lane & 3) * 8 + (size_t)(_kv < SEQ ? _kv : SEQ - 1) * 32; \
            AT_DMA(_k + (size_t)(_ka < SEQ ? _ka : SEQ - 1) * 8, kdst + (so)); AT_DMA(_k + (size_t)(_kb < SEQ ? _kb : SEQ - 1) * 8, kdst + (so) + 1024); \
            AT_DMA(_v, vdst + (so)); AT_DMA(_v + (size_t)SEQ * 32, vdst + (so) + 8192); \
        } else { \
            const bf16_t* _k = (KC) + ((size_t)wid * SEQ + _k0 + lane) * 8; const bf16_t* _kr = (KRC) + ((size_t)(wid >> 1) * SEQ + _k0 + 64 * (wid & 1) + lane) * 8; \
            const bf16_t* _v = (VC) + (size_t)(_k0 + 16 * wid) * 32 + lane * 8; \
            AT_DMA(_k, kdst + (so)); AT_DMA(_k + 64 * 8, kdst + (so) + 1024); AT_DMA(_kr, krdst + (so)); \
            AT_DMA(_v, vdst + (so)); AT_DMA(_v + (size_t)SEQ * 32, vdst + (so) + 8192); } } while (0)
    int so = so_io;
    if (wid < 4) __builtin_amdgcn_s_setprio(2);
    if (!(flags & 1)) { AT_WAIT_V(0); AT_STAGE_U(Kc, KRc, Vc, kbeg, 0, so); if (NT > 1) { const int s1 = so >= 2 * SB ? 0 : so + SB; AT_STAGE_U(Kc, KRc, Vc, kbeg, 1, s1); } }
    float qposf = 0.f;
    if (WIN) { if (tid < kend - kbeg) *(LAS float*)(lds + POSOFF + tid * 4) = posfb[kbeg + tid]; qposf = posfb[qi]; }
    bf16x8 qf[NKS];
#pragma unroll
    for (int ks = 0; ks < NKS; ++ks) qf[ks] = *(const bf16x8*)(Qp + (size_t)qi * ldq + ks * 16 + hh * 8);
    float mref = WIN ? sink2 : 0.f, lrun = (WIN && hh == 0) ? 1.f : 0.f;
    f32x16 o0, o1, negm;
#pragma unroll
    for (int i = 0; i < 16; ++i) { o0[i] = 0.f; o1[i] = 0.f; negm[i] = -mref; }
    const int vlane = (4 * hh + ((lane & 15) >> 2)) * 64 + ((lane >> 4) & 1) * 32 + (lane & 3) * 8;
    for (int t = 0; t < NT; ++t) {
        if ((t + 1 < NT) || ((flags & 2) && (t + 1 - NT) < nNT)) { if (DQK == 96) AT_WAIT_V(5); else AT_WAIT_V(4); } else AT_WAIT_V(0);
        AT_WAIT_L0(); AT_BAR();
        { const int s2 = so >= SB ? so - SB : so + 2 * SB;
          if (t + 2 < NT) AT_STAGE_U(Kc, KRc, Vc, kbeg, t + 2, s2);
          else if ((flags & 2) && (t + 2 - NT) < nNT) AT_STAGE_U(nKc, nKRc, nVc, nkbeg, t + 2 - NT, s2); }
        const int k0 = kbeg + 128 * t;
        const bool active = !WIN || (k0 + 127 >= qw0 - 128 && k0 <= qw0 + 159);
        if (active) {
            if constexpr (!WIN) {
            const LAS unsigned char* Kb = lds + so + hh * 2048 + r32 * 16;
            const LAS unsigned char* vb = lds + so + KB + vlane;
            bf16x8 kf[2 * NKS];
#pragma unroll
            for (int ks = 0; ks < NKS; ++ks) { kf[2 * ks] = *(const LAS bf16x8*)(Kb + ks * 4096); kf[2 * ks + 1] = *(const LAS bf16x8*)(Kb + ks * 4096 + 512); }
            __builtin_amdgcn_sched_barrier(0);
            f32x16 s0a, s0b, s1a, s1b;
#pragma unroll
            for (int ks = 0; ks < NKS; ++ks) {
                s0a = __builtin_amdgcn_mfma_f32_32x32x16_bf16(kf[2 * ks], qf[ks], ks == 0 ? negm : s0a, 0, 0, 0);
                s0b = __builtin_amdgcn_mfma_f32_32x32x16_bf16(kf[2 * ks + 1], qf[ks], ks == 0 ? negm : s0b, 0, 0, 0);
            }
            __builtin_amdgcn_sched_barrier(0);
#pragma unroll
            for (int ks = 0; ks < NKS; ++ks) { kf[2 * ks] = *(const LAS bf16x8*)(Kb + ks * 4096 + 1024); kf[2 * ks + 1] = *(const LAS bf16x8*)(Kb + ks * 4096 + 1536); }
            s16x4 vl0[4], vh0[4], vl1[4], vh1[4];
#pragma unroll
            for (int j = 0; j < 4; ++j) { vl0[j] = vtr(vb + j * 1024); vh0[j] = vtr(vb + j * 1024 + 512); }
            __builtin_amdgcn_sched_barrier(0);
#define AT_ROWMAX(sa, sb, rm) do { rm = __builtin_fmaxf(sa[0], sb[0]); _Pragma("unroll") for (int i = 1; i < 16; ++i) rm = __builtin_fmaxf(__builtin_fmaxf(rm, sa[i]), sb[i]); rm = xhalf_max(rm); } while (0)
#define AT_RESCALE(sa, sb, rm, first) do { if ((first) || __any(rm > 8.f)) { const float dl = (first) ? rm : fmaxf(rm, 0.f); mref += dl; const float al = (first) ? 1.f : __builtin_amdgcn_exp2f(-dl); lrun *= al; \
                _Pragma("unroll") for (int i = 0; i < 16; ++i) { negm[i] = -mref; o0[i] *= al; o1[i] *= al; sa[i] -= dl; sb[i] -= dl; } asm volatile("" : "+v"(negm)); } } while (0)
#define AT_EXPPACK(sa, sb, pk) do { float ps0 = 0.f, ps1 = 0.f; _Pragma("unroll") for (int i = 0; i < 16; ++i) { sa[i] = __builtin_amdgcn_exp2f(sa[i]); sb[i] = __builtin_amdgcn_exp2f(sb[i]); ps0 += sa[i]; ps1 += sb[i]; } lrun += ps0 + ps1; \
                _Pragma("unroll") for (int j = 0; j < 4; ++j) { u32x4 w; const int b = 8 * (j & 1); \
                    if (j < 2) { w.x = cvt_pk_bf16(sa[b], sa[b + 1]); w.y = cvt_pk_bf16(sa[b + 2], sa[b + 3]); w.z = cvt_pk_bf16(sa[b + 4], sa[b + 5]); w.w = cvt_pk_bf16(sa[b + 6], sa[b + 7]); } \
                    else { w.x = cvt_pk_bf16(sb[b], sb[b + 1]); w.y = cvt_pk_bf16(sb[b + 2], sb[b + 3]); w.z = cvt_pk_bf16(sb[b + 4], sb[b + 5]); w.w = cvt_pk_bf16(sb[b + 6], sb[b + 7]); } \
                    pk[j] = __builtin_bit_cast(bf16x8, w); } } while (0)
#define AT_VF(lo, hi, j) ((bf16x8){lo[j][0], lo[j][1], lo[j][2], lo[j][3], hi[j][0], hi[j][1], hi[j][2], hi[j][3]})
            float rm0; AT_ROWMAX(s0a, s0b, rm0);
            AT_RESCALE(s0a, s0b, rm0, (t == 0));
            __builtin_amdgcn_sched_barrier(0);
            bf16x8 pk0[4];
#pragma unroll
            for (int ks = 0; ks < NKS; ++ks) {
                s1a = __builtin_amdgcn_mfma_f32_32x32x16_bf16(kf[2 * ks], qf[ks], ks == 0 ? negm : s1a, 0, 0, 0);
                s1b = __builtin_amdgcn_mfma_f32_32x32x16_bf16(kf[2 * ks + 1], qf[ks], ks == 0 ? negm : s1b, 0, 0, 0);
            }
            AT_EXPPACK(s0a, s0b, pk0);
#pragma unroll
            for (int g = 0; g < 2 * NKS; ++g) { __builtin_amdgcn_sched_group_barrier(0x008, 1, 0); __builtin_amdgcn_sched_group_barrier(0x400, 3, 0); __builtin_amdgcn_sched_group_barrier(0x002, 4, 0); }
            __builtin_amdgcn_sched_barrier(0);
#pragma unroll
            for (int j = 0; j < 4; ++j) { vl1[j] = vtr(vb + 8192 + j * 1024); vh1[j] = vtr(vb + 8192 + j * 1024 + 512); }
            __builtin_amdgcn_sched_barrier(0);
            float rm1;
#pragma unroll
            for (int j = 0; j < 4; ++j) o0 = __builtin_amdgcn_mfma_f32_32x32x16_bf16(AT_VF(vl0, vh0, j), pk0[j], o0, 0, 0, 0);
#pragma unroll
            for (int j = 0; j < 4; ++j) o1 = __builtin_amdgcn_mfma_f32_32x32x16_bf16(AT_VF(vl1, vh1, j), pk0[j], o1, 0, 0, 0);
            AT_ROWMAX(s1a, s1b, rm1);
#pragma unroll
            for (int g = 0; g < 8; ++g) { __builtin_amdgcn_sched_group_barrier(0x008, 1, 0); __builtin_amdgcn_sched_group_barrier(0x002, 3, 0); }
            __builtin_amdgcn_sched_barrier(0);
            AT_RESCALE(s1a, s1b, rm1, false);
#pragma unroll
            for (int j = 0; j < 4; ++j) { vl0[j] = vtr(vb + (4 + j) * 1024); vh0[j] = vtr(vb + (4 + j) * 1024 + 512); }
            __builtin_amdgcn_sched_barrier(0);
            bf16x8 pk1[4];
            AT_EXPPACK(s1a, s1b, pk1);
#pragma unroll
            for (int j = 0; j < 4; ++j) { vl1[j] = vtr(vb + 8192 + (4 + j) * 1024); vh1[j] = vtr(vb + 8192 + (4 + j) * 1024 + 512); }
            __builtin_amdgcn_sched_barrier(0);
#pragma unroll
            for (int j = 0; j < 4; ++j) o0 = __builtin_amdgcn_mfma_f32_32x32x16_bf16(AT_VF(vl0, vh0, j), pk1[j], o0, 0, 0, 0);
#pragma unroll
            for (int j = 0; j < 4; ++j) o1 = __builtin_amdgcn_mfma_f32_32x32x16_bf16(AT_VF(vl1, vh1, j), pk1[j], o1, 0, 0, 0);
#undef AT_ROWMAX
#undef AT_RESCALE
#undef AT_EXPPACK
#undef AT_VF
            } else {
            const LAS unsigned char* Kb = lds + so + hh * 2048 + r32 * 16;
            const LAS unsigned char* vb = lds + so + KB + vlane;
            bf16x8 kf[2 * NKS];
            bool have = false;
#pragma unroll
            for (int h = 0; h < 2; ++h) {
                if (WIN && !(k0 + 64 * h + 63 >= qw0 - 128 && k0 + 64 * h <= qw0 + 159 && k0 + 64 * h < kend)) { have = false; continue; }
                if (!have) {
#pragma unroll
                    for (int ks = 0; ks < NKS; ++ks) { kf[2 * ks] = *(const LAS bf16x8*)(Kb + ks * 4096 + h * 1024); kf[2 * ks + 1] = *(const LAS bf16x8*)(Kb + ks * 4096 + h * 1024 + 512); }
                }
                __builtin_amdgcn_sched_barrier(0);
                f32x16 sa, sb;
#pragma unroll
                for (int ks = 0; ks < NKS; ++ks) {
                    sa = __builtin_amdgcn_mfma_f32_32x32x16_bf16(kf[2 * ks], qf[ks], ks == 0 ? negm : sa, 0, 0, 0);
                    sb = __builtin_amdgcn_mfma_f32_32x32x16_bf16(kf[2 * ks + 1], qf[ks], ks == 0 ? negm : sb, 0, 0, 0);
                }
                __builtin_amdgcn_sched_barrier(0);
                s16x4 vl0[4], vh0[4], vl1[4], vh1[4];
#pragma unroll
                for (int j = 0; j < 4; ++j) { const int s16 = 4 * h + j; vl0[j] = vtr(vb + s16 * 1024); vh0[j] = vtr(vb + s16 * 1024 + 512); }
                __builtin_amdgcn_sched_barrier(0);
                if (WIN) {
                    const int kh0 = k0 + 64 * h;
                    const bool full = (kh0 >= qw0 - 97) && (kh0 + 63 <= qw0 + 128) && (kh0 + 63 < SEQ);
                    const LAS unsigned char* pb = lds + POSOFF + (kh0 - kbeg + 4 * hh) * 4;
#pragma unroll
                    for (int gq = 0; gq < 4; ++gq) {
                        const f32x4 kpa = *(const LAS f32x4*)(pb + (8 * gq) * 4), kpb = *(const LAS f32x4*)(pb + (32 + 8 * gq) * 4);
                        const int d0 = kh0 + 8 * gq + 4 * hh - qi + 128;
#pragma unroll
                        for (int e = 0; e < 4; ++e) { const int i = 4 * gq + e;
                            const float va = fmaf(-slope2, fabsf(kpa[e] - qposf), sa[i]), vb2 = fmaf(-slope2, fabsf(kpb[e] - qposf), sb[i]);
                            sa[i] = (full || (unsigned)(d0 + e) <= (unsigned)dmax) ? va : -1e30f;
                            sb[i] = (full || (unsigned)(d0 + 32 + e) <= (unsigned)dmax) ? vb2 : -1e30f; }
                    }
                }
                float rm = __builtin_fmaxf(sa[0], sb[0]);
#pragma unroll
                for (int i = 1; i < 16; ++i) rm = __builtin_fmaxf(__builtin_fmaxf(rm, sa[i]), sb[i]);
                rm = xhalf_max(rm);
                const bool first = !WIN && (t == 0) && (h == 0);
                if (first || __any(rm > 8.f)) {
                    const float dl = first ? rm : fmaxf(rm, 0.f);
                    mref += dl;
                    const float al = first ? 1.f : __builtin_amdgcn_exp2f(-dl);
                    lrun *= al;
#pragma unroll
                    for (int i = 0; i < 16; ++i) { negm[i] = -mref; o0[i] *= al; o1[i] *= al; sa[i] -= dl; sb[i] -= dl; }
                }
                float ps0 = 0.f, ps1 = 0.f;
#pragma unroll
                for (int i = 0; i < 16; ++i) { sa[i] = __builtin_amdgcn_exp2f(sa[i]); sb[i] = __builtin_amdgcn_exp2f(sb[i]); ps0 += sa[i]; ps1 += sb[i]; }
                lrun += ps0 + ps1;
                bf16x8 pk[4];
#pragma unroll
                for (int j = 0; j < 4; ++j) { u32x4 w; const int b = 8 * (j & 1);
                    if (j < 2) { w.x = cvt_pk_bf16(sa[b], sa[b + 1]); w.y = cvt_pk_bf16(sa[b + 2], sa[b + 3]); w.z = cvt_pk_bf16(sa[b + 4], sa[b + 5]); w.w = cvt_pk_bf16(sa[b + 6], sa[b + 7]); }
                    else { w.x = cvt_pk_bf16(sb[b], sb[b + 1]); w.y = cvt_pk_bf16(sb[b + 2], sb[b + 3]); w.z = cvt_pk_bf16(sb[b + 4], sb[b + 5]); w.w = cvt_pk_bf16(sb[b + 6], sb[b + 7]); }
                    pk[j] = __builtin_bit_cast(bf16x8, w); }
#pragma unroll
                for (int j = 0; j < 4; ++j) { const int s16 = 4 * h + j; vl1[j] = vtr(vb + 8192 + s16 * 1024); vh1[j] = vtr(vb + 8192 + s16 * 1024 + 512); }
                if (h == 0 && (!WIN || (k0 + 127 >= qw0 - 128 && k0 + 64 <= qw0 + 159 && k0 + 64 < kend))) {
#pragma unroll
                    for (int ks = 0; ks < NKS; ++ks) { kf[2 * ks] = *(const LAS bf16x8*)(Kb + ks * 4096 + 1024); kf[2 * ks + 1] = *(const LAS bf16x8*)(Kb + ks * 4096 + 1536); }
                    have = true;
                }
                __builtin_amdgcn_sched_barrier(0);
#pragma unroll
                for (int j = 0; j < 4; ++j) {
                    const bf16x8 v0 = (bf16x8){vl0[j][0], vl0[j][1], vl0[j][2], vl0[j][3], vh0[j][0], vh0[j][1], vh0[j][2], vh0[j][3]};
                    o0 = __builtin_amdgcn_mfma_f32_32x32x16_bf16(v0, pk[j], o0, 0, 0, 0);
                }
#pragma unroll
                for (int j = 0; j < 4; ++j) {
                    const bf16x8 v1 = (bf16x8){vl1[j][0], vl1[j][1], vl1[j][2], vl1[j][3], vh1[j][0], vh1[j][1], vh1[j][2], vh1[j][3]};
                    o1 = __builtin_amdgcn_mfma_f32_32x32x16_bf16(v1, pk[j], o1, 0, 0, 0);
                }
            }
                    }
        }
        so = so >= 2 * SB ? 0 : so + SB;
    }
    so_io = so;
    __builtin_amdgcn_s_setprio(0);
    AT_WAIT_L0(); AT_BAR();
    const float inv = 1.f / xhalf_sum(lrun);
    bf16_t* orow = Op + (size_t)qi * ldo + 8 * hh;
#pragma unroll
    for (int gp = 0; gp < 2; ++gp)
#pragma unroll
        for (int dh = 0; dh < 2; ++dh) {
            const int ga = 2 * gp, gb = 2 * gp + 1;
            unsigned ax, ay, bx2, by2;
            if (dh == 0) { ax = cvt_pk_bf16(o0[4 * ga] * inv, o0[4 * ga + 1] * inv); ay = cvt_pk_bf16(o0[4 * ga + 2] * inv, o0[4 * ga + 3] * inv); bx2 = cvt_pk_bf16(o0[4 * gb] * inv, o0[4 * gb + 1] * inv); by2 = cvt_pk_bf16(o0[4 * gb + 2] * inv, o0[4 * gb + 3] * inv); }
            else { ax = cvt_pk_bf16(o1[4 * ga] * inv, o1[4 * ga + 1] * inv); ay = cvt_pk_bf16(o1[4 * ga + 2] * inv, o1[4 * ga + 3] * inv); bx2 = cvt_pk_bf16(o1[4 * gb] * inv, o1[4 * gb + 1] * inv); by2 = cvt_pk_bf16(o1[4 * gb + 2] * inv, o1[4 * gb + 3] * inv); }
            const auto rx = __builtin_amdgcn_permlane32_swap(ax, bx2, false, false);
            const auto ry = __builtin_amdgcn_permlane32_swap(ay, by2, false, false);
            u32x4 w; w.x = rx[0]; w.y = ry[0]; w.z = rx[1]; w.w = ry[1];
            *(u32x4*)(orow + 32 * dh + 16 * gp) = w;
        }
#undef AT_STAGE_U
}


__device__ __forceinline__ void attn_win_cu(LAS unsigned char* lds, const bf16_t* __restrict__ Qp, int ldq, const bf16_t* __restrict__ Kc, const bf16_t* __restrict__ Vc, bf16_t* Op, int ldo,
                                            const float* __restrict__ posfb, int R0, int hbase, const float* __restrict__ sinkp, const int wave_s) {
    constexpr int VOFFW = 65536, POSW = 132096, NKS = 4;
    const int tid = tid_from_wave(wave_s);
    const int lane = tid & 63, r32 = lane & 31, hh = lane >> 5;
    const int wid = __builtin_amdgcn_readfirstlane(tid >> 6);
    const int kbase = R0 - 128;
    AT_WAIT_V(0);
#pragma unroll
    for (int g = 0; g < 8; ++g) { int k = kbase + 64 * g + lane; k = k < 0 ? 0 : (k >= SEQ ? SEQ - 1 : k);
        AT_DMA(Kc + ((size_t)wid * SEQ + k) * 8, lds + wid * 8192 + g * 1024); }
#pragma unroll
    for (int pce = 0; pce < 8; ++pce) { const int id = wid * 8 + pce, dh = id >> 5, blk = id & 31; int k = kbase + 16 * blk + (lane >> 2); k = k < 0 ? 0 : (k >= SEQ ? SEQ - 1 : k);
        AT_DMA(Vc + (size_t)dh * SEQ * 32 + (size_t)k * 32 + (lane & 3) * 8, lds + VOFFW + dh * 32768 + blk * 1024); }
    { int k = kbase + tid; k = k < 0 ? 0 : (k >= SEQ ? SEQ - 1 : k); *(LAS float*)(lds + POSW + tid * 4) = posfb[k]; }
    const int h = hbase + (wid >> 1);
    const float slope2 = exp2f(-0.5f * (float)(h + 1)) * LOG2E, sink2 = sinkp[h] * LOG2E;
    const int vlane = (4 * hh + ((lane & 15) >> 2)) * 64 + ((lane >> 4) & 1) * 32 + (lane & 3) * 8;
    AT_WAIT_V(0); AT_WAIT_L0(); AT_BAR();
#pragma unroll 1
    for (int i = 0; i < 4; ++i) {
        const int qw0 = R0 + 64 * i + 32 * (wid & 1), qi = qw0 + r32;
        const int dmax = (SEQ - 1 - qi + 128) < 256 ? (SEQ - 1 - qi + 128) : 256;
        bf16x8 qf[NKS];
#pragma unroll
        for (int ks = 0; ks < NKS; ++ks) qf[ks] = *(const bf16x8*)(Qp + (size_t)qi * ldq + (wid >> 1) * 64 + ks * 16 + hh * 8);
        const float qposf = *(const LAS float*)(lds + POSW + (qi - kbase) * 4);
        float mref = sink2, lrun = (hh == 0) ? 1.f : 0.f;
        f32x16 o0, o1, negm;
#pragma unroll
        for (int e = 0; e < 16; ++e) { o0[e] = 0.f; o1[e] = 0.f; negm[e] = -mref; }
#pragma unroll 1
        for (int hf = 0; hf < 8; ++hf) {
            const int kh0 = kbase + 64 * hf;
            if (!(kh0 + 63 >= qw0 - 128 && kh0 <= qw0 + 159 && kh0 >= 0 && kh0 < SEQ)) continue;
            const LAS unsigned char* Kb = lds + hh * 8192 + (64 * hf + r32) * 16;
            const LAS unsigned char* vb = lds + VOFFW + (4 * hf) * 1024 + vlane;
            bf16x8 kf[2 * NKS];
#pragma unroll
            for (int ks = 0; ks < NKS; ++ks) { kf[2 * ks] = *(const LAS bf16x8*)(Kb + ks * 16384); kf[2 * ks + 1] = *(const LAS bf16x8*)(Kb + ks * 16384 + 512); }
            s16x4 vl0[4], vh0[4], vl1[4], vh1[4];
#pragma unroll
            for (int j = 0; j < 4; ++j) { vl0[j] = vtr(vb + j * 1024); vh0[j] = vtr(vb + j * 1024 + 512); }
            __builtin_amdgcn_sched_barrier(0);
            f32x16 sa, sb;
#pragma unroll
            for (int ks = 0; ks < NKS; ++ks) {
                sa = __builtin_amdgcn_mfma_f32_32x32x16_bf16(kf[2 * ks], qf[ks], ks == 0 ? negm : sa, 0, 0, 0);
                sb = __builtin_amdgcn_mfma_f32_32x32x16_bf16(kf[2 * ks + 1], qf[ks], ks == 0 ? negm : sb, 0, 0, 0);
            }
#pragma unroll
            for (int j = 0; j < 4; ++j) { vl1[j] = vtr(vb + 32768 + j * 1024); vh1[j] = vtr(vb + 32768 + j * 1024 + 512); }
            __builtin_amdgcn_sched_barrier(0);
            {
                const bool full = (kh0 >= qw0 - 97) && (kh0 + 63 <= qw0 + 128);
                const LAS unsigned char* pb = lds + POSW + (64 * hf + 4 * hh) * 4;
#pragma unroll
                for (int gq = 0; gq < 4; ++gq) {
                    const f32x4 kpa = *(const LAS f32x4*)(pb + (8 * gq) * 4), kpb = *(const LAS f32x4*)(pb + (32 + 8 * gq) * 4);
                    const int d0 = kh0 + 8 * gq + 4 * hh - qi + 128;
#pragma unroll
                    for (int e = 0; e < 4; ++e) { const int ii = 4 * gq + e;
                        const float va = fmaf(-slope2, fabsf(kpa[e] - qposf), sa[ii]), vb2 = fmaf(-slope2, fabsf(kpb[e] - qposf), sb[ii]);
                        sa[ii] = (full || (unsigned)(d0 + e) <= (unsigned)dmax) ? va : -1e30f;
                        sb[ii] = (full || (unsigned)(d0 + 32 + e) <= (unsigned)dmax) ? vb2 : -1e30f; }
                }
            }
            float rm = __builtin_fmaxf(sa[0], sb[0]);
#pragma unroll
            for (int e = 1; e < 16; ++e) rm = __builtin_fmaxf(__builtin_fmaxf(rm, sa[e]), sb[e]);
            rm = xhalf_max(rm);
            if (__any(rm > 8.f)) {
                const float dl = fmaxf(rm, 0.f); mref += dl; const float al = __builtin_amdgcn_exp2f(-dl); lrun *= al;
#pragma unroll
                for (int e = 0; e < 16; ++e) { negm[e] = -mref; o0[e] *= al; o1[e] *= al; sa[e] -= dl; sb[e] -= dl; }
                asm volatile("" : "+v"(negm));
            }
            float ps0 = 0.f, ps1 = 0.f;
#pragma unroll
            for (int e = 0; e < 16; ++e) { sa[e] = __builtin_amdgcn_exp2f(sa[e]); sb[e] = __builtin_amdgcn_exp2f(sb[e]); ps0 += sa[e]; ps1 += sb[e]; }
            lrun += ps0 + ps1;
            bf16x8 pk[4];
#pragma unroll
            for (int j = 0; j < 4; ++j) { u32x4 w; const int b = 8 * (j & 1);
                if (j < 2) { w.x = cvt_pk_bf16(sa[b], sa[b + 1]); w.y = cvt_pk_bf16(sa[b + 2], sa[b + 3]); w.z = cvt_pk_bf16(sa[b + 4], sa[b + 5]); w.w = cvt_pk_bf16(sa[b + 6], sa[b + 7]); }
                else { w.x = cvt_pk_bf16(sb[b], sb[b + 1]); w.y = cvt_pk_bf16(sb[b + 2], sb[b + 3]); w.z = cvt_pk_bf16(sb[b + 4], sb[b + 5]); w.w = cvt_pk_bf16(sb[b + 6], sb[b + 7]); }
                pk[j] = __builtin_bit_cast(bf16x8, w); }
#pragma unroll
            for (int j = 0; j < 4; ++j) {
                const bf16x8 v0 = (bf16x8){vl0[j][0], vl0[j][1], vl0[j][2], vl0[j][3], vh0[j][0], vh0[j][1], vh0[j][2], vh0[j][3]};
                o0 = __builtin_amdgcn_mfma_f32_32x32x16_bf16(v0, pk[j], o0, 0, 0, 0);
            }
#pragma unroll
            for (int j = 0; j < 4; ++j) {
                const bf16x8 v1 = (bf16x8){vl1[j][0], vl1[j][1], vl1[j][2], vl1[j][3], vh1[j][0], vh1[j][1], vh1[j][2], vh1[j][3]};
                o1 = __builtin_amdgcn_mfma_f32_32x32x16_bf16(v1, pk[j], o1, 0, 0, 0);
            }
        }
        const float inv = 1.f / xhalf_sum(lrun);
        bf16_t* orow = Op + (size_t)qi * ldo + (wid >> 1) * 64 + 8 * hh;
#pragma unroll
        for (int gp = 0; gp < 2; ++gp)
#pragma unroll
            for (int dh = 0; dh < 2; ++dh) {
                const int ga = 2 * gp, gb = 2 * gp + 1;
                unsigned ax, ay, bx2, by2;
                if (dh == 0) { ax = cvt_pk_bf16(o0[4 * ga] * inv, o0[4 * ga + 1] * inv); ay = cvt_pk_bf16(o0[4 * ga + 2] * inv, o0[4 * ga + 3] * inv); bx2 = cvt_pk_bf16(o0[4 * gb] * inv, o0[4 * gb + 1] * inv); by2 = cvt_pk_bf16(o0[4 * gb + 2] * inv, o0[4 * gb + 3] * inv); }
                else { ax = cvt_pk_bf16(o1[4 * ga] * inv, o1[4 * ga + 1] * inv); ay = cvt_pk_bf16(o1[4 * ga + 2] * inv, o1[4 * ga + 3] * inv); bx2 = cvt_pk_bf16(o1[4 * gb] * inv, o1[4 * gb + 1] * inv); by2 = cvt_pk_bf16(o1[4 * gb + 2] * inv, o1[4 * gb + 3] * inv); }
                const auto rx = __builtin_amdgcn_permlane32_swap(ax, bx2, false, false);
                const auto ry = __builtin_amdgcn_permlane32_swap(ay, by2, false, false);
                u32x4 w; w.x = rx[0]; w.y = ry[0]; w.z = rx[1]; w.w = ry[1];
                *(u32x4*)(orow + 32 * dh + 16 * gp) = w;
            }
    }
    AT_WAIT_L0(); AT_BAR();
}

__device__ __forceinline__ void tr_item64(const float* __restrict__ W, int N, int k0, int nsrc, const float* __restrict__ gs, bf16_t* WT, int ldk, int ndst, int lane) {
    const int rq = lane >> 4, kk = k0 + 16 * rq;
    f32x4 v[16];
    if (nsrc >= 0) {
#pragma unroll
        for (int i = 0; i < 16; ++i) v[i] = *(const f32x4*)(W + (size_t)(kk + i) * N + nsrc);
        if (gs) {
#pragma unroll
            for (int i4 = 0; i4 < 4; ++i4) { const f32x4 g4 = *(const f32x4*)(gs + kk + 4 * i4);
#pragma unroll
                for (int e = 0; e < 4; ++e) v[4 * i4 + e] = v[4 * i4 + e] * g4[e]; }
        }
    } else {
#pragma unroll
        for (int i = 0; i < 16; ++i) v[i] = (f32x4){0.f, 0.f, 0.f, 0.f};
    }
#pragma unroll
    for (int e = 0; e < 4; ++e) {
        u32x4 w0, w1;
        w0.x = cvt_pk_bf16(v[0][e], v[1][e]); w0.y = cvt_pk_bf16(v[2][e], v[3][e]); w0.z = cvt_pk_bf16(v[4][e], v[5][e]); w0.w = cvt_pk_bf16(v[6][e], v[7][e]);
        w1.x = cvt_pk_bf16(v[8][e], v[9][e]); w1.y = cvt_pk_bf16(v[10][e], v[11][e]); w1.z = cvt_pk_bf16(v[12][e], v[13][e]); w1.w = cvt_pk_bf16(v[14][e], v[15][e]);
        bf16_t* d = WT + (size_t)(ndst + e) * ldk + kk;
        *(u32x4*)d = w0; *(u32x4*)(d + 8) = w1;
    }
}

__device__ __constant__ double INV_FREQ[16] = {1.0, 0.5623413251903491, 0.31622776601683794, 0.1778279410038923, 0.1, 0.05623413251903491, 0.03162277660168379, 0.01778279410038923,
                                               0.01, 0.005623413251903491, 0.0031622776601683794, 0.0017782794100389228, 0.001, 0.0005623413251903491, 0.00031622776601683794, 0.00017782794100389227};
__device__ __forceinline__ void sincos_d(double x, float& sn, float& cs) {
    const double n = rint(x * 0.15915494309189535);
    double r = fma(-n, 6.283185307179586, x); r = fma(-n, 2.4492935982947064e-16, r);
    const double r2 = r * r; double s = 1.0, c = 1.0;
#pragma unroll
    for (int k = 12; k >= 1; --k) { s = 1.0 - r2 * (1.0 / (double)((2 * k) * (2 * k + 1))) * s; c = 1.0 - r2 * (1.0 / (double)((2 * k - 1) * (2 * k))) * c; }
    sn = (float)(r * s); cs = (float)c;
}


#define XB_TMO      128
#define XB_XCNT(j)  (256  + 64 * (j))
#define XB_XSUB(j)  (1280 + 64 * (j))
#define XB_XGEN(j)  (2304 + 64 * (j))
#define XB_TOP      3328
#define XB_TOPGEN   3392
#define XCD_BAR_WORDS 3456
#define XB_SPIN_CAP (1u << 18)
__device__ __forceinline__ unsigned xb_ld(unsigned* p)              { return __hip_atomic_load(p, __ATOMIC_RELAXED, __HIP_MEMORY_SCOPE_AGENT); }
__device__ __forceinline__ unsigned xb_add(unsigned* p, unsigned v) { return __hip_atomic_fetch_add(p, v, __ATOMIC_RELAXED, __HIP_MEMORY_SCOPE_AGENT); }
__device__ __forceinline__ unsigned xb_xcc_id() { return (unsigned)__builtin_amdgcn_s_getreg((3 << 11) | 20) & 0xFu; }
#define XB_SPIN(cond, bar) do { unsigned _sp = 0; while (cond) { __builtin_amdgcn_s_sleep(1); \
    if ((++_sp & 255u) == 0u) { if (xb_ld(&(bar)[XB_TMO])) break; if (_sp > XB_SPIN_CAP) { atomicAdd(&(bar)[XB_TMO], 1u); break; } } } } while (0)
struct XcdBarrier { unsigned* bar; unsigned x; volatile LAS unsigned* st; };
#define XB_T0(wave_s) ((wave_s) == 0 && __builtin_amdgcn_mbcnt_hi(~0u, __builtin_amdgcn_mbcnt_lo(~0u, 0u)) == 0u)
__device__ __forceinline__ XcdBarrier xcd_barrier_post(unsigned* bar, volatile LAS unsigned* st, const int wave_s) {
    XcdBarrier b; b.bar = bar; b.x = xb_xcc_id(); b.st = st;
    if (XB_T0(wave_s)) (void)xb_add(&bar[XB_XCNT(b.x)], 1u);
    return b;
}
__device__ __forceinline__ void xcd_barrier_complete(unsigned* bar, unsigned x, unsigned& nloc, unsigned& nx) {
    const unsigned G = gridDim.x * gridDim.y * gridDim.z;
    unsigned sum, cnt, mine, sp = 0u;
    for (;;) {
        sum = 0u; cnt = 0u; mine = 0u;
#pragma unroll
        for (unsigned j = 0; j < 16; ++j) { const unsigned c = xb_ld(&bar[XB_XCNT(j)]); sum += c; cnt += (c > 0u) ? 1u : 0u; mine = (j == x) ? c : mine; }
        if (sum == G) break;
        __builtin_amdgcn_s_sleep(1);
        if ((++sp & 255u) == 0u) { if (xb_ld(&bar[XB_TMO])) break; if (sp > XB_SPIN_CAP) { atomicAdd(&bar[XB_TMO], 1u); break; } }
    }
    nloc = mine > 0u ? mine : 1u; nx = cnt > 0u ? cnt : 1u;
}
__device__ __forceinline__ void xcd_local_barrier(const XcdBarrier& b, const int wave_s) {
    asm volatile("s_waitcnt vmcnt(0)" ::: "memory");
    __syncthreads();
    if (XB_T0(wave_s)) {
        unsigned* bar = b.bar;
        __builtin_amdgcn_s_waitcnt(0);
        const unsigned nloc = b.st[0];
        const unsigned old = xb_add(&bar[XB_XSUB(b.x)], 1u);
        const unsigned gen = old / nloc;
        if (old + 1u == (gen + 1u) * nloc) xb_add(&bar[XB_XGEN(b.x)], 1u);
        else XB_SPIN(xb_ld(&bar[XB_XGEN(b.x)]) == gen, bar);
        __builtin_amdgcn_fence(__ATOMIC_ACQUIRE, "agent");
        asm volatile("s_waitcnt vmcnt(0)" ::: "memory");
    }
    __syncthreads();
}
__device__ __forceinline__ void xcd_barrier(const XcdBarrier& b, const int wave_s) {
    asm volatile("s_waitcnt vmcnt(0)" ::: "memory");
    __syncthreads();
    if (XB_T0(wave_s)) {
        unsigned* bar = b.bar;
        __builtin_amdgcn_s_waitcnt(0);
        unsigned nloc = b.st[0], nx = b.st[1];
        if (nloc == 0u) { xcd_barrier_complete(bar, b.x, nloc, nx); b.st[0] = nloc; b.st[1] = nx; }
        const unsigned old = xb_add(&bar[XB_XSUB(b.x)], 1u);
        const unsigned gen = old / nloc;
        if (old + 1u == (gen + 1u) * nloc) {
            __builtin_amdgcn_fence(__ATOMIC_RELEASE, "agent");
            asm volatile("s_waitcnt vmcnt(0)" ::: "memory");
            const unsigned og = xb_add(&bar[XB_TOP], 1u);
            const unsigned tg = og / nx;
            if (og + 1u == (tg + 1u) * nx) xb_add(&bar[XB_TOPGEN], 1u);
            else XB_SPIN(xb_ld(&bar[XB_TOPGEN]) == tg, bar);
            __builtin_amdgcn_fence(__ATOMIC_ACQUIRE, "agent");
            xb_add(&bar[XB_XGEN(b.x)], 1u);
            asm volatile("s_waitcnt vmcnt(0)" ::: "memory");
        } else {
            XB_SPIN(xb_ld(&bar[XB_XGEN(b.x)]) == gen, bar);
            __builtin_amdgcn_fence(__ATOMIC_ACQUIRE, "agent");
            asm volatile("s_waitcnt vmcnt(0)" ::: "memory");
        }
    }
    __syncthreads();
}


__device__ __forceinline__ unsigned char* opq(unsigned char* p) { asm volatile("" : "+s"(p)); return p; }
#define P_HB(w) ((bf16_t*)((w) + WS_HB))
#define P_R0(w) ((bf16_t*)((w) + WS_R0))
#define P_KVM(w) ((bf16_t*)((w) + WS_KVM))
#define P_OB(w) ((bf16_t*)((w) + WS_O))
#define P_KR(w) ((bf16_t*)((w) + WS_KR))
#define P_LAT(w) ((bf16_t*)((w) + WS_LAT))
#define P_SSQH(w) ((float*)((w) + WS_SSQH))
#define P_SSQL(w) ((float*)((w) + WS_SSQL))
#define P_COS(w) ((float*)((w) + WS_COS))
#define P_SIN(w) ((float*)((w) + WS_SIN))
#define P_POSF(w) ((float*)((w) + WS_POSF))


#define CONVERT_LAYER(LY, PARTS, wk, nwk, lane_) do { \
    const int ly_ = (LY), j_ = ly_ >> 1, cg4_ = 4 * ((lane_) & 15); \
    constexpr int I0 = 384, I1 = 256, I2 = 192, I3 = 144, I4 = 128, I6 = 1408, I7 = 704; \
    const int nmix_ = (ly_ & 1) ? (I2 + I3 + I4 + I1) : (I0 + I1); \
    const int lo_ = ((PARTS) & 1) ? 0 : nmix_, hi_ = ((PARTS) & 2) ? nmix_ + I6 + I7 : nmix_; \
    for (int it_ = lo_ + (wk); it_ < hi_; it_ += (nwk)) { \
        int r = it_; \
        if (r >= nmix_) { r -= nmix_; \
            if (r < I6) { const int kb = r / 88, nd = (r % 88) * 64 + cg4_; const int ns = ((nd >> 7) & 1) * DFF + (nd >> 8) * 128 + (nd & 127); \
                tr_item64(ffn_w_gu + (size_t)ly_ * DM * GU, GU, kb * 64, ns, norm_ffn + ly_ * DM, (bf16_t*)(ws + WS_WGU + ly_ * SZ_WGU), DM, nd, (lane_)); } \
            else { r -= I6; const int kb = r / 16, nd = (r % 16) * 64 + cg4_; \
                tr_item64(ffn_w_down + (size_t)ly_ * DFF * DM, DM, kb * 64, nd, nullptr, (bf16_t*)(ws + WS_WDN + ly_ * SZ_WDN), DFF, nd, (lane_)); } \
        } else if ((ly_ & 1) == 0) { \
            if (r < I0) { const int kb = r / 24, nd = (r % 24) * 64 + cg4_; \
                tr_item64(a_w_qkv + (size_t)j_ * DM * AQKV, AQKV, kb * 64, nd, norm_mix + ly_ * DM, (bf16_t*)(ws + WS_WQKV + j_ * SZ_WQKV), DM, nd, (lane_)); } \
            else { r -= I0; const int kb = r / 16, nd = (r % 16) * 64 + cg4_; \
                tr_item64(a_w_o + (size_t)j_ * DM * DM, DM, kb * 64, nd, nullptr, (bf16_t*)(ws + WS_WOA + j_ * SZ_WO), DM, nd, (lane_)); } \
        } else { \
            if (r < I2) { const int kb = r / 12, nd = (r % 12) * 64 + cg4_; const int ns = nd < 256 ? 384 + nd : (nd < 640 ? nd - 256 : (nd < 672 ? nd : -1)); \
                tr_item64(b_w_in + (size_t)j_ * DM * BIN, BIN, kb * 64, ns, norm_mix + ly_ * DM, (bf16_t*)(ws + WS_WIN + j_ * SZ_WIN), DM, nd, (lane_)); } \
            else if (r < I2 + I3) { r -= I2; const int kb = r / 24, nd = (r % 24) * 64 + cg4_; \
                tr_item64(b_w_uq + (size_t)j_ * QL * UQ, UQ, kb * 64, nd, b_g_q + j_ * QL, (bf16_t*)(ws + WS_WUQ + j_ * SZ_WUQ), QL, nd, (lane_)); } \
            else if (r < I2 + I3 + I4) { r -= I2 + I3; const int kb = r / 32, nd = (r % 32) * 64 + cg4_; \
                tr_item64(b_w_ukv + (size_t)j_ * KVL * UKV, UKV, kb * 64, nd, b_g_kv + j_ * KVL, (bf16_t*)(ws + WS_WUKV + j_ * SZ_WUKV), KVL, nd, (lane_)); } \
            else { r -= I2 + I3 + I4; const int kb = r / 16, nd = (r % 16) * 64 + cg4_; \
                tr_item64(b_w_o + (size_t)j_ * DM * DM, DM, kb * 64, nd, nullptr, (bf16_t*)(ws + WS_WOB + j_ * SZ_WO), DM, nd, (lane_)); } \
        } \
    } } while (0)

struct Params { const float* in[16]; float* out; unsigned char* ws; };

__global__ void __launch_bounds__(512, 2) mk_fwd(Params P) {
    extern __shared__ __attribute__((aligned(16))) unsigned char lds_raw[];
    LAS unsigned char* lds = (LAS unsigned char*)lds_raw;
    cg::grid_group grid = cg::this_grid();
    const int wave_s = __builtin_amdgcn_readfirstlane((int)threadIdx.x >> 6);
    const int G = gridDim.x, bx = blockIdx.x;
    const int vcu = (G % 8 == 0) ? (bx % 8) * (G / 8) + bx / 8 : bx;
    unsigned char* ws = P.ws;
    const float* x = P.in[0]; const int* positions = (const int*)P.in[1];
    const float *norm_mix = P.in[2], *norm_ffn = P.in[3], *a_w_qkv = P.in[4], *a_sink = P.in[5], *a_w_o = P.in[6], *b_w_in = P.in[7], *b_g_q = P.in[8], *b_g_kv = P.in[9],
                *b_w_uq = P.in[10], *b_w_ukv = P.in[11], *b_w_o = P.in[12], *ffn_w_gu = P.in[13], *ffn_w_down = P.in[14], *final_norm = P.in[15];
    float* out = P.out;
    unsigned* barw = (unsigned*)ws;
    volatile LAS unsigned* xst = (volatile LAS unsigned*)(lds + 131072 + 512);
    { const int t0 = tid_from_wave(wave_s); if (t0 < 4) xst[t0] = 0u; }
    __syncthreads();
    bf16_t* hb = (bf16_t*)(ws + WS_HB); bf16_t* r0 = (bf16_t*)(ws + WS_R0); bf16_t* kvm = (bf16_t*)(ws + WS_KVM); bf16_t* ob = (bf16_t*)(ws + WS_O); bf16_t* latb = (bf16_t*)(ws + WS_O);
    bf16_t* krb = (bf16_t*)(ws + WS_KR); float* ssqh = (float*)(ws + WS_SSQH); float* ssql = (float*)(ws + WS_SSQL); float* cosT = (float*)(ws + WS_COS); float* sinT = (float*)(ws + WS_SIN); float* posf = (float*)(ws + WS_POSF);

    XcdBarrier xbar; xbar.bar = barw; xbar.st = xst; xbar.x = xb_xcc_id();
    if (XB_T0(wave_s)) {
        const unsigned rk = xb_add(&barw[XB_XCNT(xbar.x)], 1u);
        unsigned nloc, nx; xcd_barrier_complete(barw, xbar.x, nloc, nx);
        unsigned ok = (G % 8 == 0 && xbar.x < 8u) ? 1u : 0u;
#pragma unroll
        for (unsigned jx = 0; jx < 8; ++jx) if (xb_ld(&barw[XB_XCNT(jx)]) != (unsigned)(G / 8)) ok = 0u;
        xst[0] = nloc; xst[1] = nx; xst[2] = rk; xst[3] = ok;
    }
    __syncthreads();
    const int lmode = __builtin_amdgcn_readfirstlane((int)xst[3]);
    const int xrank = __builtin_amdgcn_readfirstlane((int)xst[2]);
    const int cid = lmode ? xrank * 8 + (int)xbar.x : bx;
    const int cidr = lmode ? (G / 8 - 1 - xrank) * 8 + (int)xbar.x : G - 1 - bx;
    const int vcu2 = lmode ? (int)xbar.x * (G / 8) + xrank : vcu;
    for (int rep = 0; rep < REP_PRO; ++rep) {
        const int tid = tid_from_wave(wave_s);
        const int lane = tid & 63, wave = __builtin_amdgcn_readfirstlane(tid >> 6);
        const int gw = vcu * 8 + wave, NGW = G * 8;
        CONVERT_LAYER(0, 1, gw, NGW, lane);
        for (int m = gw; m < T; m += NGW) {
            const f32x4* xr = (const f32x4*)(x + (size_t)m * DM) + lane; f32x4 v[4]; float s = 0.f;
#pragma unroll
            for (int j = 0; j < 4; ++j) { v[j] = xr[64 * j]; s += dot4(v[j]); }
            s = wave_sum(s);
            u32x2* o8 = (u32x2*)(hb + (size_t)m * DM) + lane;
#pragma unroll
            for (int j = 0; j < 4; ++j) { u32x2 w; w.x = cvt_pk_bf16(v[j][0], v[j][1]); w.y = cvt_pk_bf16(v[j][2], v[j][3]); o8[64 * j] = w; }
            if (lane < 16) ssqh[(size_t)m * 16 + lane] = (lane == 0) ? s : 0.f;
        }
        for (int idx = (vcu * 512 + tid); idx < T * 16; idx += G * 512) { const int t = idx >> 4, i = idx & 15; float sn, cs; sincos_d((double)positions[t] * INV_FREQ[i], sn, cs); cosT[idx] = cs; sinT[idx] = sn; if (i == 0) posf[t] = (float)positions[t]; }
    }
    if (gridDim.y > 1u) grid.sync();
    GSYNC();

#pragma unroll 1
    for (int layer = 0; layer < 4; ++layer) {
        const int j = layer >> 1;
        if ((layer & 1) == 0) {
            { unsigned char* wsl = opq(ws); pg8::Gemm g{P_HB(wsl), (const bf16_t*)(wsl + WS_WQKV + j * SZ_WQKV), T, AQKV, DM, DM}; pg8::StaticOrder S; S.init(T, AQKV, G, cid);
              EpiQkvA E{P_R0(wsl), P_KVM(wsl), P_KVM(wsl) + (size_t)T * 256, (RowScale{P_SSQH(wsl), 16, 0, 4, 1.f / 1024.f}), 0.125f * LOG2E};
              pg8::gemm_phase<EpiQkvA, pg8::StaticOrder, true>(lds, g, S, E, wave_s); }
            if (layer == 0) {
                const int busy = ((T / 256) * (AQKV / 256)) % G;
                const int tid = tid_from_wave(wave_s); const int lane = tid & 63, wave = __builtin_amdgcn_readfirstlane(tid >> 6);
                if (busy == 0) CONVERT_LAYER(0, 2, cid * 8 + wave, G * 8, lane);
                else if (cid >= busy) CONVERT_LAYER(0, 2, (cid - busy) * 8 + wave, (G - busy) * 8, lane);
            }
            GSYNC_L();
            if (G == 256) { unsigned char* wsl = opq(ws);
              const int b = vcu2 >> 5, kvh = (vcu2 >> 3) & 3, R0 = (vcu2 & 7) * 256; const size_t rb = (size_t)b * SEQ;
              attn_win_cu(lds, P_R0(wsl) + rb * AQKV + kvh * 256, AQKV, P_KVM(wsl) + (size_t)(b * 4 + kvh) * 8 * SEQ * 8, P_KVM(wsl) + (size_t)T * 256 + (size_t)(b * 4 + kvh) * 2 * SEQ * 32,
                          P_OB(wsl) + rb * DM + kvh * 256, DM, P_POSF(wsl) + rb, R0, kvh * 4, a_sink + j * 16, wave_s);
            } else
            for (int rep = 0; rep < REP_ATT; ++rep) { unsigned char* wsl = opq(ws); const int nper = (1024 + G - 1) / G;
              const int u0 = vcu2 * nper, u1 = ((vcu2 + 1) * nper < 1024) ? (vcu2 + 1) * nper : 1024; int ring = 0;
              for (int ui = u0; ui < u1; ++ui) {
                  const int b = ui >> 7, kvh = (ui >> 5) & 3, qb = ui & 31;
                  const int un = ui + 1, nb = un >> 7, nkvh = (un >> 5) & 3, nqb = un & 31;
                  const size_t rb = (size_t)b * SEQ;
                  attn_unit2<64, true>(lds, P_R0(wsl) + rb * AQKV + kvh * 256, AQKV, P_KVM(wsl) + (size_t)(b * 4 + kvh) * 8 * SEQ * 8, nullptr, P_KVM(wsl) + (size_t)T * 256 + (size_t)(b * 4 + kvh) * 2 * SEQ * 32,
                                      P_OB(wsl) + rb * DM + kvh * 256, DM, P_POSF(wsl) + rb, qb * 64, kvh * 4, a_sink + j * 16, wave_s,
                                      P_KVM(wsl) + (size_t)(nb * 4 + nkvh) * 8 * SEQ * 8, nullptr, P_KVM(wsl) + (size_t)T * 256 + (size_t)(nb * 4 + nkvh) * 2 * SEQ * 32, nqb * 64,
                                      (ui > u0 ? 1 : 0) | (un < u1 ? 2 : 0), ring);
              } }
            GSYNC_L();
        } else {
            { unsigned char* wsl = opq(ws); pg8::Gemm g{P_HB(wsl), (const bf16_t*)(wsl + WS_WIN + j * SZ_WIN), T, BINP, DM, DM}; pg8::StaticOrder S; S.init(T, BINP, G, cid);
              EpiLat E{P_LAT(wsl), P_SSQL(wsl), P_KR(wsl), P_COS(wsl), P_SIN(wsl), (RowScale{P_SSQH(wsl), 16, 0, 4, 1.f / 1024.f})};
              pg8::gemm_phase<EpiLat, pg8::StaticOrder, true>(lds, g, S, E, wave_s); }
            GSYNC_L();
            { unsigned char* wsl = opq(ws); pg8::Gemm g{P_LAT(wsl) + 256, (const bf16_t*)(wsl + WS_WUQ + j * SZ_WUQ), T, UQ, QL, BINP}; pg8::StaticOrder S; S.init(T, UQ, G, cid);
              EpiUq E{P_R0(wsl), P_COS(wsl), P_SIN(wsl), RowScale{P_SSQL(wsl), 24, 8, 3, 1.f / 384.f}, 0.10206207261596575f * LOG2E};
              pg8::gemm_phase<EpiUq, pg8::StaticOrder, true>(lds, g, S, E, wave_s); }
            { unsigned char* wsl = opq(ws); pg8::Gemm g{P_LAT(wsl), (const bf16_t*)(wsl + WS_WUKV + j * SZ_WUKV), T, UKV, KVL, BINP}; pg8::StaticOrder S; S.init(T, UKV, G, cidr);
              EpiKvB E{P_KVM(wsl), P_KVM(wsl) + (size_t)T * 1024, RowScale{P_SSQL(wsl), 24, 0, 2, 1.f / 256.f}};
              pg8::gemm_phase<EpiKvB, pg8::StaticOrder, true>(lds, g, S, E, wave_s); }
            GSYNC_L();
            for (int rep = 0; rep < REP_ATT; ++rep) { unsigned char* wsl = opq(ws); const int nper = (1024 + G - 1) / G;
              const int u0 = vcu2 * nper, u1 = ((vcu2 + 1) * nper < 1024) ? (vcu2 + 1) * nper : 1024; int ring = 0;
              for (int ui = u0; ui < u1; ++ui) {
                  int bh = ui >> 3, qb = ui & 7, nbh = (ui + 1) >> 3;
                  if (G == 256) { const int stepi = ui - u0; bh = (vcu2 >> 5) * 16 + ((vcu2 & 31) >> 3) + 4 * stepi; qb = vcu2 & 7; nbh = bh + 4; }
                  const int b = bh >> 4, h = bh & 15;
                  const int un = ui + 1, nb = nbh >> 4, nh = nbh & 15;
                  const size_t rb = (size_t)b * SEQ;
                  attn_unit2<96, false>(lds, P_R0(wsl) + rb * UQ + h * 96, UQ, P_KVM(wsl) + (size_t)(b * 16 + h) * 8 * SEQ * 8, P_KR(wsl) + (size_t)b * 4 * SEQ * 8, P_KVM(wsl) + (size_t)T * 1024 + (size_t)(b * 16 + h) * 2 * SEQ * 32,
                                       P_OB(wsl) + rb * DM + h * 64, DM, P_POSF(wsl) + rb, qb * 256, 0, nullptr, wave_s,
                                       P_KVM(wsl) + (size_t)(nb * 16 + nh) * 8 * SEQ * 8, P_KR(wsl) + (size_t)nb * 4 * SEQ * 8, P_KVM(wsl) + (size_t)T * 1024 + (size_t)(nb * 16 + nh) * 2 * SEQ * 32, (un & 7) * 256,
                                       (ui > u0 ? 1 : 0) | (un < u1 ? 2 : 0), ring);
              } }
            GSYNC_L();
        }
        { unsigned char* wsl = opq(ws); const bf16_t* wo = (layer & 1) ? (const bf16_t*)(wsl + WS_WOB + j * SZ_WO) : (const bf16_t*)(wsl + WS_WOA + j * SZ_WO);
          pg8::Gemm g{P_OB(wsl), wo, T, DM, DM, DM}; pg8::StaticOrder S; S.init(T, DM, G, cid);
          EpiResid E{P_HB(wsl), P_SSQH(wsl)};
          pg8::gemm_phase<EpiResid, pg8::StaticOrder, true>(lds, g, S, E, wave_s); }
        GSYNC();
        { unsigned char* wsl = opq(ws); pg8::Gemm g{P_HB(wsl), (const bf16_t*)(wsl + WS_WGU + layer * SZ_WGU), T, GU, DM, DM}; pg8::StaticOrder S; S.init(T, GU, G, cid);
          EpiSwiglu E{P_R0(wsl), (RowScale{P_SSQH(wsl), 16, 0, 4, 1.f / 1024.f})};
          pg8::gemm_phase<EpiSwiglu, pg8::StaticOrder, true>(lds, g, S, E, wave_s); }
        if (layer < 3) {
            const int busy = ((T / 256) * (GU / 256)) % G;
            const int tid = tid_from_wave(wave_s); const int lane = tid & 63, wave = __builtin_amdgcn_readfirstlane(tid >> 6);
            if (busy == 0) CONVERT_LAYER(layer + 1, 3, cid * 8 + wave, G * 8, lane);
            else if (cid >= busy) CONVERT_LAYER(layer + 1, 3, (cid - busy) * 8 + wave, (G - busy) * 8, lane);
        }
        GSYNC_L();
        { unsigned char* wsl = opq(ws); pg8::Gemm g{P_R0(wsl), (const bf16_t*)(wsl + WS_WDN + layer * SZ_WDN), T, DM, DFF, DFF}; pg8::StaticOrder S; S.init(T, DM, G, cid);
          EpiResid E{P_HB(wsl), P_SSQH(wsl)};
          pg8::gemm_phase<EpiResid, pg8::StaticOrder, true>(lds, g, S, E, wave_s); }
        GSYNC();
    }
    {
        const int tid = tid_from_wave(wave_s);
        const int lane = tid & 63, wave = __builtin_amdgcn_readfirstlane(tid >> 6);
        const int gw = vcu * 8 + wave, NGW = G * 8;
        for (int m = gw; m < T; m += NGW) {
            float s = (lane < 16) ? ssqh[(size_t)m * 16 + lane] : 0.f; s = wave_sum(s);
            const float rstd = rsqrtf(s * (1.f / 1024.f) + EPSN);
            const u32x2* hr = (const u32x2*)(hb + (size_t)m * DM) + lane; f32x4* xr = (f32x4*)(out + (size_t)m * DM) + lane; const f32x4* gr = (const f32x4*)final_norm + lane;
#pragma unroll
            for (int jj = 0; jj < 4; ++jj) { const u32x2 w = hr[64 * jj]; f32x4 v; v[0] = __uint_as_float(w.x << 16); v[1] = __uint_as_float(w.x & 0xffff0000u); v[2] = __uint_as_float(w.y << 16); v[3] = __uint_as_float(w.y & 0xffff0000u);
                xr[64 * jj] = v * rstd * gr[64 * jj]; }
        }
    }
}

extern "C" void kernel_launch(void* const* d_in, const int* in_sizes, int n_in, void* d_out, int out_size, void* d_ws, size_t ws_size, hipStream_t stream) {
    static int grid = 0;
    if (grid == 0) {
        if (n_in != 16 || out_size != T * DM || ws_size < WS_END) { fprintf(stderr, "kernel_launch: unexpected shapes (n_in %d out %d ws %zu need %zu)\n", n_in, out_size, ws_size, (size_t)WS_END); grid = -1; return; }
        int dev = 0, cus = 0, per_cu = 0;
        hipGetDevice(&dev); hipDeviceGetAttribute(&cus, hipDeviceAttributeMultiprocessorCount, dev);
        if (hipFuncSetAttribute((const void*)mk_fwd, hipFuncAttributeMaxDynamicSharedMemorySize, LDS_BYTES) != hipSuccess) { fprintf(stderr, "kernel_launch: hipFuncSetAttribute failed\n"); grid = -1; return; }
        if (hipOccupancyMaxActiveBlocksPerMultiprocessor(&per_cu, (const void*)mk_fwd, 512, LDS_BYTES) != hipSuccess || per_cu < 1) { fprintf(stderr, "kernel_launch: occupancy query says %d\n", per_cu); per_cu = 1; }
        (void)hipGetLastError();
        grid = cus;
    }
    if (grid < 0) return;
    if (hipMemsetAsync(d_ws, 0, 16384, stream) != hipSuccess) { fprintf(stderr, "kernel_launch: hipMemsetAsync of the barrier words failed\n"); return; }
    Params p{};
    for (int i = 0; i < 16; ++i) p.in[i] = (const float*)d_in[i];
    p.out = (float*)d_out; p.ws = (unsigned char*)d_ws;
    void* args[] = {&p};
    hipError_t e = hipLaunchCooperativeKernel((const void*)mk_fwd, dim3(grid), dim3(512), args, LDS_BYTES, stream);
    if (e != hipSuccess) fprintf(stderr, "cooperative launch failed: %s (grid %d)\n", hipGetErrorString(e), grid);
}
```

```cpp
#include <hip/hip_runtime.h>
#include <hip/hip_cooperative_groups.h>
#include <cstdio>
#include <cstdint>
namespace cg = cooperative_groups;

#define LAS __attribute__((address_space(3)))
typedef unsigned short bf16_t;
typedef short bf16x8 __attribute__((ext_vector_type(8)));
typedef short s16x4 __attribute__((ext_vector_type(4)));
typedef float f32x4 __attribute__((ext_vector_type(4)));
typedef float f32x16 __attribute__((ext_vector_type(16)));
typedef unsigned u32x4 __attribute__((ext_vector_type(4)));
typedef unsigned u32x2 __attribute__((ext_vector_type(2)));
typedef int i32x4 __attribute__((ext_vector_type(4)));

constexpr int NB = 8, SEQ = 2048, DM = 1024, T = NB * SEQ;
constexpr int AQKV = 1536, BIN = 672, BINP = 768, QL = 384, KVL = 256, UQ = 1536, UKV = 2048, DFF = 2816, GU = 2 * DFF;
constexpr float EPSN = 1e-6f;
constexpr float LOG2E = 1.4426950408889634f;

constexpr size_t MiB = 1u << 20;
constexpr size_t SZ_WQKV = (size_t)AQKV * DM * 2, SZ_WO = (size_t)DM * DM * 2, SZ_WIN = (size_t)BINP * DM * 2, SZ_WUQ = (size_t)UQ * QL * 2,
                 SZ_WUKV = (size_t)UKV * KVL * 2, SZ_WGU = (size_t)GU * DM * 2, SZ_WDN = (size_t)DM * DFF * 2;
constexpr size_t WS_WQKV = 1 * MiB;
constexpr size_t WS_WOA = WS_WQKV + 2 * SZ_WQKV;
constexpr size_t WS_WIN = WS_WOA + 2 * SZ_WO;
constexpr size_t WS_WUQ = WS_WIN + 2 * SZ_WIN;
constexpr size_t WS_WUKV = WS_WUQ + 2 * SZ_WUQ;
constexpr size_t WS_WOB = WS_WUKV + 2 * SZ_WUKV;
constexpr size_t WS_WGU = WS_WOB + 2 * SZ_WO;
constexpr size_t WS_WDN = WS_WGU + 4 * SZ_WGU;
constexpr size_t WS_WEND = WS_WDN + 4 * SZ_WDN;
constexpr size_t WS_HB = 90 * MiB;
constexpr size_t WS_R0 = 122 * MiB;
constexpr size_t WS_KVM = WS_R0 + 48 * MiB;
constexpr size_t WS_O = WS_KVM + 64 * MiB;
constexpr size_t WS_KR = WS_O + 32 * MiB;
constexpr size_t WS_SSQH = WS_KR + 1 * MiB;
constexpr size_t WS_SSQL = WS_SSQH + 1 * MiB;
constexpr size_t WS_COS = WS_SSQL + 2 * MiB;
constexpr size_t WS_SIN = WS_COS + 1 * MiB;
constexpr size_t WS_POSF = WS_SIN + 1 * MiB;
constexpr size_t WS_LAT = WS_POSF + 1 * MiB;
constexpr size_t WS_END = WS_LAT + 24 * MiB;
static_assert(WS_WEND <= WS_HB, "weights overflow");
static_assert((size_t)T * DFF * 2 <= 112 * MiB, "act overlay");

constexpr int LDS_BYTES = 147456;
#ifndef REP_SYNC
#define REP_SYNC 1
#endif
#ifndef REP_ATT
#define REP_ATT 1
#endif
#ifndef REP_PRO
#define REP_PRO 1
#endif
#define GSYNC() do { for (int _r = 0; _r < REP_SYNC; ++_r) xcd_barrier(xbar, wave_s); } while (0)
#define GSYNC_L() do { if (lmode) xcd_local_barrier(xbar, wave_s); else xcd_barrier(xbar, wave_s); } while (0)

__device__ __forceinline__ int tid_from_wave(int wave_s) { int t = wave_s * 64 + (int)__builtin_amdgcn_mbcnt_hi(~0u, __builtin_amdgcn_mbcnt_lo(~0u, 0u)); asm volatile("" : "+v"(t)); return t; }
typedef float f32x2_t __attribute__((ext_vector_type(2))); typedef __bf16 bf16x2_t __attribute__((ext_vector_type(2)));
__device__ __forceinline__ unsigned cvt_pk_bf16(float lo, float hi) { const f32x2_t v = {lo, hi}; const bf16x2_t b = __builtin_convertvector(v, bf16x2_t); return __builtin_bit_cast(unsigned, b); }
__device__ __forceinline__ float xhalf_max(float m) { auto rr = __builtin_amdgcn_permlane32_swap(__float_as_uint(m), __float_as_uint(m), false, false); return fmaxf(__uint_as_float(rr[0]), __uint_as_float(rr[1])); }
__device__ __forceinline__ float xhalf_sum(float m) { auto rr = __builtin_amdgcn_permlane32_swap(__float_as_uint(m), __float_as_uint(m), false, false); return __uint_as_float(rr[0]) + __uint_as_float(rr[1]); }
template <int K> __device__ __forceinline__ float xor_lane(float v) { return __int_as_float(__builtin_amdgcn_ds_swizzle(__float_as_int(v), (K << 10) | 0x1f)); }
__device__ __forceinline__ float wave_sum(float v) {
    v += xor_lane<1>(v); v += xor_lane<2>(v); v += xor_lane<4>(v); v += xor_lane<8>(v); v += xor_lane<16>(v);
    return xhalf_sum(v);
}

namespace pg8 {
constexpr int BM = 256, BK = 64, HALF = 128, HTB = HALF * BK * 2, STAGE_BYTES = 8 * HTB, NXCD = 8, WGM = 8;
__host__ __device__ __forceinline__ int lds_byte(int r, int c) { const int st = (r >> 4) * 2 + (c >> 5), rr = r & 15, cc = c & 31, ob = rr * 64 + cc * 2; return st * 1024 + (ob ^ (((ob >> 9) & 1) << 5)); }
__host__ __device__ __forceinline__ void stage_rc(int b, int& R, int& C) { const int st = b / 1024, sb = b % 1024, swz = sb ^ (((sb >> 9) & 1) << 5); R = (st >> 1) * 16 + swz / 64; C = (st & 1) * 32 + (swz % 64) / 2; }
__host__ __device__ __forceinline__ int perm32(int rho) { const int n = rho >> 4, i = rho & 15; return 8 * (i >> 2) + 4 * n + (i & 3); }
struct Unit { int pm, pn; };
struct Gemm { const bf16_t* A; const bf16_t* Bt; int M, N, K, lda; };
struct StaticOrder {
    int nM, nN, nwg, G, c;
    __device__ void init(int M, int N, int G_, int c_) { nM = M / BM; nN = N / BM; nwg = nM * nN; G = G_; c = c_; }
    __device__ bool next(int i, Unit& u) const {
        const long L = (long)i * G + c; if (L >= nwg) return false;
        int wgid = (int)L; { const int q = nwg / NXCD, r = nwg % NXCD, xcd = wgid % NXCD, off = wgid / NXCD; wgid = (xcd < r ? xcd * (q + 1) : r * (q + 1) + (xcd - r) * q) + off; }
        const int nig = WGM * nN, gid = wgid / nig, fm = gid * WGM, gsz = (nM - fm) < WGM ? (nM - fm) : WGM;
        u.pm = fm + ((wgid % nig) % gsz); u.pn = (wgid % nig) / gsz; return true;
    }
};

template <class Epi, class Sched, bool ALIGN_EPI>
__device__ __forceinline__ void gemm_phase(LAS unsigned char* lds, const Gemm g, const Sched& S, const Epi& E, const int wave_s) {
    const int tid = tid_from_wave(wave_s);
    const int wid = __builtin_amdgcn_readfirstlane(tid >> 6), lane = tid & 63, wr = wid >> 2, wc = wid & 3, fr = lane & 15, fq = lane >> 4;
    const int K = g.K, nt = K / BK, lda = g.lda;
    unsigned voffA[2], voffB[2];
#pragma unroll
    for (int i = 0; i < 2; ++i) { int R, C; stage_rc(tid * 16 + i * 8192, R, C); const int Rb = Epi::PERM ? ((R & ~31) + perm32(R & 31)) : R;
        voffA[i] = (unsigned)(R * lda + C) * 2u; voffB[i] = (unsigned)(Rb * K + C) * 2u; }
    const size_t kstep = (size_t)(BK * 2);
    const size_t hstepA = (size_t)HALF * lda * 2, hstepB = (size_t)HALF * K * 2;
    const size_t tstepA = 2 * hstepA, tstepB = 2 * hstepB;
    const unsigned ldsw = (unsigned)wid * 1024u;
    const int aoff = lds_byte(wr * 64 + fr, fq * 8), boff = lds_byte(wc * 32 + fr, fq * 8);
#define PG8_SA(b, h) (((b) * 2 + (h)) * HTB)
#define PG8_SB(b, h) ((4 + (b) * 2 + (h)) * HTB)
#define PG8_STAGE(bufoff, gbase, voff) do { _Pragma("unroll") for (int _i = 0; _i < 2; ++_i) \
        __builtin_amdgcn_global_load_lds((const unsigned*)((const char*)(gbase) + (voff)[_i]), (LAS unsigned*)(lds + (bufoff) + ldsw + _i * 8192), 16, 0, 0); } while (0)
#define PG8_LDA(dst, b, h) do { _Pragma("unroll") for (int m = 0; m < 4; ++m) _Pragma("unroll") for (int k = 0; k < 2; ++k) dst[m][k] = *(const LAS bf16x8*)(lds + PG8_SA(b, h) + aoff + m * 2048 + k * 1024); } while (0)
#define PG8_LDB(dst, b, h) do { _Pragma("unroll") for (int n = 0; n < 2; ++n) _Pragma("unroll") for (int k = 0; k < 2; ++k) dst[n][k] = *(const LAS bf16x8*)(lds + PG8_SB(b, h) + boff + n * 2048 + k * 1024); } while (0)
#define PG8_MMA(ai, bj, At, Bt) do { __builtin_amdgcn_s_setprio(1); _Pragma("unroll") for (int m = 0; m < 4; ++m) _Pragma("unroll") for (int n = 0; n < 2; ++n) _Pragma("unroll") for (int k = 0; k < 2; ++k) \
        acc[ai][bj][m][n] = __builtin_amdgcn_mfma_f32_16x16x32_bf16(Bt[n][k], At[m][k], acc[ai][bj][m][n], 0, 0, 0); __builtin_amdgcn_s_setprio(0); } while (0)
#define PG8_WAIT_V(n) asm volatile("s_waitcnt vmcnt(" #n ")" ::: "memory")
#define PG8_WAIT_L(n) asm volatile("s_waitcnt lgkmcnt(" #n ")" ::: "memory")
#define PG8_BAR __builtin_amdgcn_s_barrier()
#define PG8_SCHED __builtin_amdgcn_sched_barrier(0)
    Unit cur, nxt; int ui = 0;
    if (!S.next(0, cur)) return;
    f32x4 acc[2][2][4][2];
    if constexpr (Epi::ACC_INIT) E.init(acc, cur, wr, wc, fr, fq);
    else {
#pragma unroll
    for (int a = 0; a < 2; ++a)
#pragma unroll
        for (int b = 0; b < 2; ++b)
#pragma unroll
            for (int m = 0; m < 4; ++m)
#pragma unroll
                for (int n = 0; n < 2; ++n) acc[a][b][m][n] = (f32x4){0.f, 0.f, 0.f, 0.f};
    }
    bf16x8 At[4][2], B0[2][2], B1[2][2];
    const char* cA = (const char*)g.A + (size_t)cur.pm * tstepA; const char* cB = (const char*)g.Bt + (size_t)cur.pn * tstepB;
    PG8_STAGE(PG8_SB(0, 0), cB, voffB); PG8_STAGE(PG8_SB(0, 1), cB + hstepB, voffB); PG8_STAGE(PG8_SA(0, 0), cA, voffA); PG8_STAGE(PG8_SA(0, 1), cA + hstepA, voffA);
    if (wr == 1) PG8_BAR;
    PG8_WAIT_V(2); PG8_BAR;
    PG8_STAGE(PG8_SB(1, 0), cB + kstep, voffB); PG8_STAGE(PG8_SA(1, 0), cA + kstep, voffA); PG8_STAGE(PG8_SB(1, 1), cB + hstepB + kstep, voffB);
    PG8_WAIT_V(6); PG8_BAR;
    for (;;) {
        const bool has_next = S.next(ui + 1, nxt);
        const char* nA = has_next ? (const char*)g.A + (size_t)nxt.pm * tstepA : cA; const char* nB = has_next ? (const char*)g.Bt + (size_t)nxt.pn * tstepB : cB;
#pragma unroll 1
        for (int t = 0; t < nt; t += 2) {
            const bool last = (t == nt - 2);
            const char* a1 = cA + (size_t)(t + 1) * kstep;
            const char* a2 = last ? nA : cA + (size_t)(t + 2) * kstep; const char* b2 = last ? nB : cB + (size_t)(t + 2) * kstep;
            const char* a3 = a2 + kstep; const char* b3 = b2 + kstep;
            PG8_LDB(B0, 0, 0); PG8_LDB(B1, 0, 1); PG8_SCHED; PG8_LDA(At, 0, 0); PG8_STAGE(PG8_SA(1, 1), a1 + hstepA, voffA);
            PG8_WAIT_V(8); PG8_WAIT_L(0); PG8_BAR; PG8_MMA(0, 0, At, B0); PG8_MMA(0, 1, At, B1); PG8_BAR; PG8_SCHED;
            PG8_LDA(At, 0, 1); PG8_STAGE(PG8_SB(0, 0), b2, voffB); PG8_STAGE(PG8_SB(0, 1), b2 + hstepB, voffB); PG8_STAGE(PG8_SA(0, 0), a2, voffA);
            PG8_WAIT_V(8); PG8_WAIT_L(0); PG8_BAR; PG8_MMA(1, 0, At, B0); PG8_MMA(1, 1, At, B1); PG8_BAR; PG8_SCHED;
            PG8_LDB(B0, 1, 0); PG8_LDB(B1, 1, 1); PG8_SCHED; PG8_LDA(At, 1, 0); PG8_STAGE(PG8_SA(0, 1), a2 + hstepA, voffA);
            PG8_WAIT_V(8); PG8_WAIT_L(0); PG8_BAR; PG8_MMA(0, 0, At, B0); PG8_MMA(0, 1, At, B1); PG8_BAR; PG8_SCHED;
            PG8_LDA(At, 1, 1); PG8_STAGE(PG8_SB(1, 0), b3, voffB); PG8_STAGE(PG8_SB(1, 1), b3 + hstepB, voffB); PG8_STAGE(PG8_SA(1, 0), a3, voffA);
            PG8_WAIT_V(8); PG8_WAIT_L(0); PG8_BAR; PG8_MMA(1, 0, At, B0); PG8_MMA(1, 1, At, B1); PG8_BAR; PG8_SCHED;
        }
        if constexpr (ALIGN_EPI) { if (wr == 0) PG8_BAR; }
        { const int l2 = tid_from_wave(wave_s) & 63; E(acc, cur, wr, wc, l2 & 15, l2 >> 4); }
        if (!has_next) break;
        if constexpr (Epi::ACC_INIT) { const int l3 = tid_from_wave(wave_s) & 63; E.init(acc, nxt, wr, wc, l3 & 15, l3 >> 4); }
        else {
#pragma unroll
        for (int a = 0; a < 2; ++a)
#pragma unroll
            for (int b = 0; b < 2; ++b)
#pragma unroll
                for (int m = 0; m < 4; ++m)
#pragma unroll
                    for (int n = 0; n < 2; ++n) acc[a][b][m][n] = (f32x4){0.f, 0.f, 0.f, 0.f};
        }
        cur = nxt; cA = nA; cB = nB; ++ui;
        if constexpr (ALIGN_EPI) { if (wr == 1) PG8_BAR; }
    }
    PG8_WAIT_V(0);
    if constexpr (!ALIGN_EPI) { if (wr == 0) PG8_BAR; }
    PG8_BAR;
#undef PG8_SA
#undef PG8_SB
#undef PG8_STAGE
#undef PG8_LDA
#undef PG8_LDB
#undef PG8_MMA
#undef PG8_WAIT_V
#undef PG8_WAIT_L
#undef PG8_BAR
#undef PG8_SCHED
}
}

typedef f32x4 AccT[2][2][4][2];
struct RowScale { const float* ssq; int stride, off, n4; float inv_dim; };
__device__ __forceinline__ void load_rstd(float (&rs)[2][4], const RowScale& R, int row0, int fq) {
#pragma unroll
    for (int ai = 0; ai < 2; ++ai)
#pragma unroll
        for (int m = 0; m < 4; ++m) {
            const int row = row0 + ai * 128 + m * 16;
            f32x4 v = (f32x4){0.f, 0.f, 0.f, 0.f};
            if (fq < R.n4) v = *(const f32x4*)(R.ssq + (size_t)row * R.stride + R.off + 4 * fq);
            float s = (v[0] + v[1]) + (v[2] + v[3]);
            s += xor_lane<16>(s); s = xhalf_sum(s);
            rs[ai][m] = rsqrtf(s * R.inv_dim + EPSN);
        }
}
__device__ __forceinline__ float dot4(f32x4 v) { return (v[0] * v[0] + v[1] * v[1]) + (v[2] * v[2] + v[3] * v[3]); }

struct EpiBf16S {
    static constexpr bool PERM = true, ACC_INIT = false;
    bf16_t* O; int ldc; RowScale R; int scale_tiles; float scale0;
    __device__ __forceinline__ void operator()(const AccT& acc, const pg8::Unit& u, int wr, int wc, int fr, int fq) const {
        const int row0 = u.pm * 256 + wr * 64 + fr;
        float rs[2][4]; load_rstd(rs, R, row0, fq);
        const float sc = (u.pn < scale_tiles) ? scale0 : 1.f;
        const int col0 = u.pn * 256 + wc * 32 + 8 * fq;
#pragma unroll
        for (int ai = 0; ai < 2; ++ai)
#pragma unroll
            for (int m = 0; m < 4; ++m) { bf16_t* rowp = O + (size_t)(row0 + ai * 128 + m * 16) * ldc + col0; const float f = rs[ai][m] * sc;
#pragma unroll
                for (int bj = 0; bj < 2; ++bj) { const f32x4 v0 = acc[ai][bj][m][0] * f, v1 = acc[ai][bj][m][1] * f;
                    u32x4 w; w.x = cvt_pk_bf16(v0[0], v0[1]); w.y = cvt_pk_bf16(v0[2], v0[3]); w.z = cvt_pk_bf16(v1[0], v1[1]); w.w = cvt_pk_bf16(v1[2], v1[3]);
                    *(u32x4*)(rowp + bj * 128) = w; } }
    }
};

struct EpiQkvA {
    static constexpr bool PERM = true, ACC_INIT = false;
    bf16_t* Q; bf16_t* Kc; bf16_t* Vc; RowScale R; float scale0;
    __device__ __forceinline__ void operator()(const AccT& acc, const pg8::Unit& u, int wr, int wc, int fr, int fq) const {
        const int row0 = u.pm * 256 + wr * 64 + fr;
        float rs[2][4]; load_rstd(rs, R, row0, fq);
        const float sc = (u.pn < 4) ? scale0 : 1.f;
#pragma unroll
        for (int ai = 0; ai < 2; ++ai)
#pragma unroll
            for (int m = 0; m < 4; ++m) { const int row = row0 + ai * 128 + m * 16; const int b = row >> 11, key = row & 2047; const float f = rs[ai][m] * sc;
#pragma unroll
                for (int bj = 0; bj < 2; ++bj) { const f32x4 v0 = acc[ai][bj][m][0] * f, v1 = acc[ai][bj][m][1] * f;
                    u32x4 w; w.x = cvt_pk_bf16(v0[0], v0[1]); w.y = cvt_pk_bf16(v0[2], v0[3]); w.z = cvt_pk_bf16(v1[0], v1[1]); w.w = cvt_pk_bf16(v1[2], v1[3]);
                    const int cc = bj * 128 + wc * 32 + 8 * fq, kvh = cc >> 6, e6 = cc & 63;
                    bf16_t* dst;
                    if (u.pn < 4) dst = Q + (size_t)row * AQKV + u.pn * 256 + cc;
                    else if (u.pn == 4) dst = Kc + ((size_t)((b * 4 + kvh) * 8 + (e6 >> 3)) * SEQ + key) * 8;
                    else dst = Vc + ((size_t)((b * 4 + kvh) * 2 + (e6 >> 5)) * SEQ + key) * 32 + (e6 & 31);
                    *(u32x4*)dst = w; } }
    }
};
struct EpiKvB {
    static constexpr bool PERM = true, ACC_INIT = false;
    bf16_t* Kc; bf16_t* Vc; RowScale R;
    __device__ __forceinline__ void operator()(const AccT& acc, const pg8::Unit& u, int wr, int wc, int fr, int fq) const {
        const int row0 = u.pm * 256 + wr * 64 + fr;
        float rs[2][4]; load_rstd(rs, R, row0, fq);
        const int cc = wc * 32 + 8 * fq;
#pragma unroll
        for (int ai = 0; ai < 2; ++ai)
#pragma unroll
            for (int m = 0; m < 4; ++m) { const int row = row0 + ai * 128 + m * 16; const int b = row >> 11, key = row & 2047; const float f = rs[ai][m];
#pragma unroll
                for (int bj = 0; bj < 2; ++bj) { const f32x4 v0 = acc[ai][bj][m][0] * f, v1 = acc[ai][bj][m][1] * f;
                    u32x4 w; w.x = cvt_pk_bf16(v0[0], v0[1]); w.y = cvt_pk_bf16(v0[2], v0[3]); w.z = cvt_pk_bf16(v1[0], v1[1]); w.w = cvt_pk_bf16(v1[2], v1[3]);
                    const int h = u.pn * 2 + bj;
                    bf16_t* dst;
                    if (wc < 2) dst = Kc + ((size_t)((b * 16 + h) * 8 + (cc >> 3)) * SEQ + key) * 8;
                    else dst = Vc + ((size_t)((b * 16 + h) * 2 + ((cc - 64) >> 5)) * SEQ + key) * 32 + ((cc - 64) & 31);
                    *(u32x4*)dst = w; } }
    }
};
__device__ __forceinline__ float silu_mul(float g, float u) { return g * __builtin_amdgcn_rcpf(1.f + __expf(-g)) * u; }
struct EpiSwiglu {
    static constexpr bool PERM = true, ACC_INIT = false;
    bf16_t* O; RowScale R;
    __device__ __forceinline__ void operator()(const AccT& acc, const pg8::Unit& u, int wr, int wc, int fr, int fq) const {
        const int row0 = u.pm * 256 + wr * 64 + fr;
        float rs[2][4]; load_rstd(rs, R, row0, fq);
        const int col0 = u.pn * 128 + wc * 32 + 8 * fq;
#pragma unroll
        for (int ai = 0; ai < 2; ++ai)
#pragma unroll
            for (int m = 0; m < 4; ++m) { bf16_t* rowp = O + (size_t)(row0 + ai * 128 + m * 16) * DFF + col0; const float f = rs[ai][m];
                const float c1 = -f * LOG2E, f2 = f * f;
                const f32x4 g0 = acc[ai][0][m][0], g1 = acc[ai][0][m][1], u0 = acc[ai][1][m][0], u1 = acc[ai][1][m][1];
#define SG_(g, u) (((g) * (u)) * (f2 * __builtin_amdgcn_rcpf(1.f + __builtin_amdgcn_exp2f((g) * c1))))
                u32x4 w; w.x = cvt_pk_bf16(SG_(g0[0], u0[0]), SG_(g0[1], u0[1])); w.y = cvt_pk_bf16(SG_(g0[2], u0[2]), SG_(g0[3], u0[3]));
                w.z = cvt_pk_bf16(SG_(g1[0], u1[0]), SG_(g1[1], u1[1])); w.w = cvt_pk_bf16(SG_(g1[2], u1[2]), SG_(g1[3], u1[3]));
#undef SG_
                *(u32x4*)rowp = w; }
    }
};
struct EpiResid {
    static constexpr bool PERM = true, ACC_INIT = true;
    bf16_t* hb; float* ssq;
    __device__ __forceinline__ void init(AccT& acc, const pg8::Unit& u, int wr, int wc, int fr, int fq) const {
        const int row0 = u.pm * 256 + wr * 64 + fr; const int col0 = u.pn * 256 + wc * 32 + 8 * fq;
#pragma unroll
        for (int ai = 0; ai < 2; ++ai)
#pragma unroll
            for (int m = 0; m < 4; ++m) { const bf16_t* rp = hb + (size_t)(row0 + ai * 128 + m * 16) * DM + col0;
#pragma unroll
                for (int bj = 0; bj < 2; ++bj) { const u32x4 o = *(const u32x4*)(rp + bj * 128);
                    acc[ai][bj][m][0] = (f32x4){__uint_as_float(o.x << 16), __uint_as_float(o.x & 0xffff0000u), __uint_as_float(o.y << 16), __uint_as_float(o.y & 0xffff0000u)};
                    acc[ai][bj][m][1] = (f32x4){__uint_as_float(o.z << 16), __uint_as_float(o.z & 0xffff0000u), __uint_as_float(o.w << 16), __uint_as_float(o.w & 0xffff0000u)}; } }
    }
    __device__ __forceinline__ void operator()(const AccT& acc, const pg8::Unit& u, int wr, int wc, int fr, int fq) const {
        const int row0 = u.pm * 256 + wr * 64 + fr; const int col0 = u.pn * 256 + wc * 32 + 8 * fq;
#pragma unroll
        for (int ai = 0; ai < 2; ++ai)
#pragma unroll
            for (int m = 0; m < 4; ++m) { const int row = row0 + ai * 128 + m * 16; bf16_t* rp = hb + (size_t)row * DM + col0; float ss = 0.f;
#pragma unroll
                for (int bj = 0; bj < 2; ++bj) { const f32x4 v0 = acc[ai][bj][m][0], v1 = acc[ai][bj][m][1];
                    ss += dot4(v0) + dot4(v1);
                    u32x4 w; w.x = cvt_pk_bf16(v0[0], v0[1]); w.y = cvt_pk_bf16(v0[2], v0[3]); w.z = cvt_pk_bf16(v1[0], v1[1]); w.w = cvt_pk_bf16(v1[2], v1[3]);
                    *(u32x4*)(rp + bj * 128) = w; }
                ss += xor_lane<16>(ss); ss = xhalf_sum(ss);
                if (fq == 0) ssq[(size_t)row * 16 + u.pn * 4 + wc] = ss; }
    }
};
struct EpiLat {
    static constexpr bool PERM = false, ACC_INIT = false;
    bf16_t* lat; float* ssql; bf16_t* kr; const float* cosT; const float* sinT; RowScale R;
    __device__ __forceinline__ void operator()(const AccT& acc, const pg8::Unit& u, int wr, int wc, int fr, int fq) const {
        const int row0 = u.pm * 256 + wr * 64 + fr; const int col0 = u.pn * 256 + wc * 32 + 4 * fq;
        float rs[2][4]; load_rstd(rs, R, row0, fq);
#pragma unroll
        for (int ai = 0; ai < 2; ++ai)
#pragma unroll
            for (int m = 0; m < 4; ++m) { const int row = row0 + ai * 128 + m * 16; const float f = rs[ai][m];
#pragma unroll
                for (int bj = 0; bj < 2; ++bj) { float ss = 0.f;
#pragma unroll
                    for (int n = 0; n < 2; ++n) { const f32x4 v = acc[ai][bj][m][n] * f; ss += dot4(v); u32x2 w; w.x = cvt_pk_bf16(v[0], v[1]); w.y = cvt_pk_bf16(v[2], v[3]);
                        *(u32x2*)(lat + (size_t)row * BINP + col0 + bj * 128 + n * 16) = w; }
                    ss += xor_lane<16>(ss); ss = xhalf_sum(ss);
                    if (fq == 0) ssql[(size_t)row * 24 + u.pn * 8 + bj * 4 + wc] = ss; }
                if (u.pn == 2 && wc == 0) { const f32x4 t1 = acc[ai][1][m][0] * f, t2 = acc[ai][1][m][1] * f;
                    const f32x4 c = *(const f32x4*)(cosT + (size_t)row * 16 + 4 * fq), s = *(const f32x4*)(sinT + (size_t)row * 16 + 4 * fq);
                    const f32x4 o1 = t1 * c - t2 * s, o2 = t1 * s + t2 * c; u32x2 w1, w2; w1.x = cvt_pk_bf16(o1[0], o1[1]); w1.y = cvt_pk_bf16(o1[2], o1[3]); w2.x = cvt_pk_bf16(o2[0], o2[1]); w2.y = cvt_pk_bf16(o2[2], o2[3]);
                    const int b = row >> 11, key = row & 2047; bf16_t* kd = kr + ((size_t)(b * 4 + (fq >> 1)) * SEQ + key) * 8 + 4 * (fq & 1); *(u32x2*)kd = w1; *(u32x2*)(kd + (size_t)2 * SEQ * 8) = w2; } }
    }
};
struct EpiUq {
    static constexpr bool PERM = false, ACC_INIT = false;
    bf16_t* qm; const float* cosT; const float* sinT; RowScale R; float qscale;
    __device__ __forceinline__ void operator()(const AccT& acc, const pg8::Unit& u, int wr, int wc, int fr, int fq) const {
        const int row0 = u.pm * 256 + wr * 64 + fr; const int col0 = u.pn * 256 + wc * 32 + 4 * fq;
        float rs[2][4]; load_rstd(rs, R, row0, fq);
        const int G0 = u.pn * 8 + wc; const bool rp0 = (G0 % 3) == 2, rp1 = ((G0 + 4) % 3) == 2;
#pragma unroll
        for (int ai = 0; ai < 2; ++ai)
#pragma unroll
            for (int m = 0; m < 4; ++m) { const int row = row0 + ai * 128 + m * 16; const float f = rs[ai][m] * qscale;
                f32x4 c = (f32x4){1.f, 1.f, 1.f, 1.f}, s = (f32x4){0.f, 0.f, 0.f, 0.f};
                if (rp0 || rp1) { c = *(const f32x4*)(cosT + (size_t)row * 16 + 4 * fq); s = *(const f32x4*)(sinT + (size_t)row * 16 + 4 * fq); }
#pragma unroll
                for (int bj = 0; bj < 2; ++bj) { f32x4 v0 = acc[ai][bj][m][0] * f, v1 = acc[ai][bj][m][1] * f;
                    if (bj == 0 ? rp0 : rp1) { const f32x4 a = v0 * c - v1 * s, b = v0 * s + v1 * c; v0 = a; v1 = b; }
                    u32x2 w0, w1; w0.x = cvt_pk_bf16(v0[0], v0[1]); w0.y = cvt_pk_bf16(v0[2], v0[3]); w1.x = cvt_pk_bf16(v1[0], v1[1]); w1.y = cvt_pk_bf16(v1[2], v1[3]);
                    bf16_t* p = qm + (size_t)row * UQ + col0 + bj * 128; *(u32x2*)p = w0; *(u32x2*)(p + 16) = w1; } }
    }
};

__device__ __forceinline__ s16x4 vtr(const LAS unsigned char* p) { typedef short v4i16_t __attribute__((ext_vector_type(4))); return __builtin_bit_cast(s16x4, __builtin_amdgcn_ds_read_tr16_b64_v4i16((LAS v4i16_t*)p)); }

template <int DQK, bool WIN>
__device__ __forceinline__ void attn_unit(LAS unsigned char* lds, const bf16_t* __restrict__ Qp, int ldq, const bf16_t* __restrict__ Kp, int ldk, const bf16_t* __restrict__ KRp,
                                          const bf16_t* __restrict__ Vp, int ldv, bf16_t* Op, int ldo, const int* __restrict__ posb, int q0, float slope2, float sink2, const int wave_s) {
    constexpr int KS = DQK * 2 + 16, KBYTES = 64 * KS, VOFF = 2 * KBYTES, VBYTES = 8192, NKS = DQK / 16;
    const int tid = tid_from_wave(wave_s);
    const int lane = tid & 63, r32 = lane & 31, hh = lane >> 5;
    const int wid = __builtin_amdgcn_readfirstlane(tid >> 6);
    const int qw0 = q0 + wid * 32;
    int kbeg = 0, kend = SEQ;
    if (WIN) { kbeg = q0 - 128 < 0 ? 0 : q0 - 128; kend = q0 + 384 > SEQ ? SEQ : q0 + 384; }
    const int NT = (kend - kbeg) >> 6;
    bf16x8 qf[NKS];
#pragma unroll
    for (int ks = 0; ks < NKS; ++ks) qf[ks] = *(const bf16x8*)(Qp + (size_t)(qw0 + r32) * ldq + ks * 16 + hh * 8);
    const int skey = tid >> 3, sc8 = tid & 7;
    const bf16_t* kg = Kp + (size_t)(kbeg + skey) * ldk + sc8 * 8;
    const bf16_t* vg = Vp + (size_t)(kbeg + skey) * ldv + sc8 * 8;
    const int kl = skey * KS + sc8 * 16;
    const int vl = VOFF + ((skey >> 3) * 2 + (sc8 >> 2)) * 512 + (skey & 7) * 64 + (sc8 & 3) * 16;
    const bf16_t* krg = KRp + (size_t)(kbeg + (tid >> 2)) * 32 + (tid & 3) * 8;
    const int krl = (tid >> 2) * KS + 128 + (tid & 3) * 16;
    const bool has_kr = (DQK == 96) && (tid < 256);
    u32x4 kreg, vreg, krreg = (u32x4){0u, 0u, 0u, 0u};
    kreg = *(const u32x4*)kg; vreg = *(const u32x4*)vg; if (has_kr) krreg = *(const u32x4*)krg;
    *(LAS u32x4*)(lds + kl) = kreg; *(LAS u32x4*)(lds + vl) = vreg; if (has_kr) *(LAS u32x4*)(lds + krl) = krreg;
    __syncthreads();
    float mrun = WIN ? sink2 : -1e30f, lrun = (WIN && hh == 0) ? 1.f : 0.f;
    f32x16 o0, o1;
#pragma unroll
    for (int i = 0; i < 16; ++i) { o0[i] = 0.f; o1[i] = 0.f; }
    const int qi = qw0 + r32; int qpos = 0; if (WIN) qpos = posb[qi];
    const int vlane = (4 * hh + ((lane & 15) >> 2)) * 64 + ((lane >> 4) & 1) * 32 + (lane & 3) * 8;
    for (int t = 0; t < NT; ++t) {
        const int buf = t & 1;
        if (t + 1 < NT) { kreg = *(const u32x4*)(kg + (size_t)(t + 1) * 64 * ldk); vreg = *(const u32x4*)(vg + (size_t)(t + 1) * 64 * ldv); if (has_kr) krreg = *(const u32x4*)(krg + (size_t)(t + 1) * 64 * 32); }
        const int k0 = kbeg + 64 * t;
        const bool active = !WIN || (k0 + 63 >= qw0 - 128 && k0 <= qw0 + 31 + 128);
        if (active) {
            const LAS unsigned char* Kb = lds + buf * KBYTES + r32 * KS + hh * 16;
            f32x16 s0, s1;
#pragma unroll
            for (int i = 0; i < 16; ++i) { s0[i] = 0.f; s1[i] = 0.f; }
#pragma unroll
            for (int ks = 0; ks < NKS; ++ks) {
                const bf16x8 a0 = *(const LAS bf16x8*)(Kb + ks * 32);
                const bf16x8 a1 = *(const LAS bf16x8*)(Kb + 32 * KS + ks * 32);
                s0 = __builtin_amdgcn_mfma_f32_32x32x16_bf16(a0, qf[ks], s0, 0, 0, 0);
                s1 = __builtin_amdgcn_mfma_f32_32x32x16_bf16(a1, qf[ks], s1, 0, 0, 0);
            }
            if (WIN) {
#pragma unroll
                for (int gq = 0; gq < 4; ++gq) {
                    const int kb0 = k0 + 8 * gq + 4 * hh;
                    const i32x4 kp0 = *(const i32x4*)(posb + kb0), kp1 = *(const i32x4*)(posb + kb0 + 32);
#pragma unroll
                    for (int e = 0; e < 4; ++e) { const int i = 4 * gq + e; const int d0 = kb0 + e - qi, d1 = d0 + 32;
                        const int p0 = kp0[e] - qpos, p1 = kp1[e] - qpos;
                        const float f0 = (float)(p0 < 0 ? -p0 : p0), f1 = (float)(p1 < 0 ? -p1 : p1);
                        s0[i] = (d0 >= -128 && d0 <= 128) ? (s0[i] - slope2 * f0) : -1e30f;
                        s1[i] = (d1 >= -128 && d1 <= 128) ? (s1[i] - slope2 * f1) : -1e30f; }
                }
            }
            float mx = fmaxf(s0[0], s1[0]);
#pragma unroll
            for (int i = 1; i < 16; ++i) mx = fmaxf(mx, fmaxf(s0[i], s1[i]));
            mx = xhalf_max(mx);
            const float mnew = fmaxf(mrun, mx);
            const float alpha = __builtin_amdgcn_exp2f(mrun - mnew);
            mrun = mnew;
            float ps = 0.f;
#pragma unroll
            for (int i = 0; i < 16; ++i) { s0[i] = __builtin_amdgcn_exp2f(s0[i] - mnew); s1[i] = __builtin_amdgcn_exp2f(s1[i] - mnew); ps += s0[i] + s1[i]; }
            lrun = lrun * alpha + ps;
#pragma unroll
            for (int i = 0; i < 16; ++i) { o0[i] *= alpha; o1[i] *= alpha; }
            bf16x8 pk[4];
#pragma unroll
            for (int s = 0; s < 4; ++s) { u32x4 w;
                if (s < 2) { const int b = 8 * s; w.x = cvt_pk_bf16(s0[b], s0[b + 1]); w.y = cvt_pk_bf16(s0[b + 2], s0[b + 3]); w.z = cvt_pk_bf16(s0[b + 4], s0[b + 5]); w.w = cvt_pk_bf16(s0[b + 6], s0[b + 7]); }
                else { const int b = 8 * (s - 2); w.x = cvt_pk_bf16(s1[b], s1[b + 1]); w.y = cvt_pk_bf16(s1[b + 2], s1[b + 3]); w.z = cvt_pk_bf16(s1[b + 4], s1[b + 5]); w.w = cvt_pk_bf16(s1[b + 6], s1[b + 7]); }
                pk[s] = __builtin_bit_cast(bf16x8, w); }
            const LAS unsigned char* vb = lds + VOFF + buf * VBYTES + vlane;
#pragma unroll
            for (int s = 0; s < 4; ++s) {
                const s16x4 l0 = vtr(vb + (4 * s + 0) * 512), h0 = vtr(vb + (4 * s + 2) * 512);
                const s16x4 l1 = vtr(vb + (4 * s + 1) * 512), h1 = vtr(vb + (4 * s + 3) * 512);
                const bf16x8 v0 = (bf16x8){l0[0], l0[1], l0[2], l0[3], h0[0], h0[1], h0[2], h0[3]};
                const bf16x8 v1 = (bf16x8){l1[0], l1[1], l1[2], l1[3], h1[0], h1[1], h1[2], h1[3]};
                o0 = __builtin_amdgcn_mfma_f32_32x32x16_bf16(v0, pk[s], o0, 0, 0, 0);
                o1 = __builtin_amdgcn_mfma_f32_32x32x16_bf16(v1, pk[s], o1, 0, 0, 0);
            }
        }
        if (t + 1 < NT) { const int nb = buf ^ 1; *(LAS u32x4*)(lds + nb * KBYTES + kl) = kreg; *(LAS u32x4*)(lds + nb * VBYTES + vl) = vreg; if (has_kr) *(LAS u32x4*)(lds + nb * KBYTES + krl) = krreg; }
        __syncthreads();
    }
    const float inv = 1.f / xhalf_sum(lrun);
    bf16_t* orow = Op + (size_t)qi * ldo + 4 * hh;
#pragma unroll
    for (int gq = 0; gq < 4; ++gq) {
        u32x2 w0, w1;
        w0.x = cvt_pk_bf16(o0[4 * gq] * inv, o0[4 * gq + 1] * inv); w0.y = cvt_pk_bf16(o0[4 * gq + 2] * inv, o0[4 * gq + 3] * inv);
        w1.x = cvt_pk_bf16(o1[4 * gq] * inv, o1[4 * gq + 1] * inv); w1.y = cvt_pk_bf16(o1[4 * gq + 2] * inv, o1[4 * gq + 3] * inv);
        *(u32x2*)(orow + 8 * gq) = w0; *(u32x2*)(orow + 32 + 8 * gq) = w1;
    }
}


#define AT_WAIT_V(n) asm volatile("s_waitcnt vmcnt(" #n ")" ::: "memory")
#define AT_WAIT_L0() asm volatile("s_waitcnt lgkmcnt(0)" ::: "memory")
#define AT_BAR() do { __builtin_amdgcn_s_barrier(); asm volatile("" ::: "memory"); } while (0)
#define AT_DMA(gp, lp) __builtin_amdgcn_global_load_lds((const unsigned*)(gp), (LAS unsigned*)(lp), 16, 0, 0)
template <int DQK, bool WIN>
__device__ __forceinline__ void attn_unit2(LAS unsigned char* lds, const bf16_t* __restrict__ Qp, int ldq, const bf16_t* __restrict__ Kc, const bf16_t* __restrict__ KRc,
                                           const bf16_t* __restrict__ Vc, bf16_t* Op, int ldo, const float* __restrict__ posfb, int q0, int hbase, const float* __restrict__ sinkp, const int wave_s,
                                           const bf16_t* __restrict__ nKc, const bf16_t* __restrict__ nKRc, const bf16_t* __restrict__ nVc, int nq0, int flags, int& so_io) {
    constexpr int NCH = DQK / 8, KB = NCH * 2048, SB = KB + 16384, POSOFF = 3 * SB, NKS = DQK / 16;
    static_assert(POSOFF + 2048 <= 131072, "attention LDS");
    const int tid = tid_from_wave(wave_s);
    const int lane = tid & 63, r32 = lane & 31, hh = lane >> 5;
    const int wid = __builtin_amdgcn_readfirstlane(tid >> 6);
    const int qw0 = WIN ? q0 + (wid & 1) * 32 : q0 + wid * 32, qi = qw0 + r32;
    int kbeg = 0, kend = SEQ;
    if (WIN) { kbeg = q0 - 128 < 0 ? 0 : q0 - 128; kend = q0 + 192 > SEQ ? SEQ : q0 + 192; Qp += (wid >> 1) * 64; Op += (wid >> 1) * 64; }
    const int NT = (kend - kbeg + 127) >> 7;
    float slope2 = 0.f, sink2 = 0.f;
    if (WIN) { const int h = hbase + (wid >> 1); slope2 = exp2f(-0.5f * (float)(h + 1)) * LOG2E; sink2 = sinkp[h] * LOG2E; }
    const int dmax = (SEQ - 1 - qi + 128) < 256 ? (SEQ - 1 - qi + 128) : 256;
    int nkbeg = 0, nNT = SEQ >> 7;
    if (WIN) { nkbeg = nq0 - 128 < 0 ? 0 : nq0 - 128; const int nkend = nq0 + 192 > SEQ ? SEQ : nq0 + 192; nNT = (nkend - nkbeg + 127) >> 7; }
    LAS unsigned char* kdst = lds + wid * 2048;
    LAS unsigned char* krdst = lds + (8 + (wid >> 1)) * 2048 + (wid & 1) * 1024;
    LAS unsigned char* vdst = lds + KB + wid * 1024;
#define AT_STAGE_U(KC, KRC, VC, KBEG, t, so) do { const int _k0 = (KBEG) + (t) * 128; \
        if (WIN) {   \
            const int _ka = _k0 + lane, _kb = _ka + 64, _kv = _k0 + 16 * wid + (lane >> 2); \
            const bf16_t* _k = (KC) + (size_t)wid * SEQ * 8; const bf16_t* _v = (VC) + (lane & 3) * 8 + (size_t)(_kv < SEQ ? _kv : SEQ - 1) * 32; \
            AT_DMA(_k + (size_t)(_ka < SEQ ? _ka : SEQ - 1) * 8, kdst + (so)); AT_DMA(_k + (size_t)(_kb < SEQ ? _kb : SEQ - 1) * 8, kdst + (so) + 1024); \
            AT_DMA(_v, vdst + (so)); AT_DMA(_v + (size_t)SEQ * 32, vdst + (so) + 8192); \
        } else { \
            const bf16_t* _k = (KC) + ((size_t)wid * SEQ + _k0 + lane) * 8; const bf16_t* _kr = (KRC) + ((size_t)(wid >> 1) * SEQ + _k0 + 64 * (wid & 1) + lane) * 8; \
            const bf16_t* _v = (VC) + (size_t)(_k0 + 16 * wid) * 32 + lane * 8; \
            AT_DMA(_k, kdst + (so)); AT_DMA(_k + 64 * 8, kdst + (so) + 1024); AT_DMA(_kr, krdst + (so)); \
            AT_DMA(_v, vdst + (so)); AT_DMA(_v + (size_t)SEQ * 32, vdst + (so) + 8192); } } while (0)
    int so = so_io;
    if (wid < 4) __builtin_amdgcn_s_setprio(2);
    if (!(flags & 1)) { AT_WAIT_V(0); AT_STAGE_U(Kc, KRc, Vc, kbeg, 0, so); if (NT > 1) { const int s1 = so >= 2 * SB ? 0 : so + SB; AT_STAGE_U(Kc, KRc, Vc, kbeg, 1, s1); } }
    float qposf = 0.f;
    if (WIN) { if (tid < kend - kbeg) *(LAS float*)(lds + POSOFF + tid * 4) = posfb[kbeg + tid]; qposf = posfb[qi]; }
    bf16x8 qf[NKS];
#pragma unroll
    for (int ks = 0; ks < NKS; ++ks) qf[ks] = *(const bf16x8*)(Qp + (size_t)qi * ldq + ks * 16 + hh * 8);
    float mref = WIN ? sink2 : 0.f, lrun = (WIN && hh == 0) ? 1.f : 0.f;
    f32x16 o0, o1, negm;
#pragma unroll
    for (int i = 0; i < 16; ++i) { o0[i] = 0.f; o1[i] = 0.f; negm[i] = -mref; }
    const int vlane = (4 * hh + ((lane & 15) >> 2)) * 64 + ((lane >> 4) & 1) * 32 + (lane & 3) * 8;
    for (int t = 0; t < NT; ++t) {
        if ((t + 1 < NT) || ((flags & 2) && (t + 1 - NT) < nNT)) { if (DQK == 96) AT_WAIT_V(5); else AT_WAIT_V(4); } else AT_WAIT_V(0);
        AT_WAIT_L0(); AT_BAR();
        { const int s2 = so >= SB ? so - SB : so + 2 * SB;
          if (t + 2 < NT) AT_STAGE_U(Kc, KRc, Vc, kbeg, t + 2, s2);
          else if ((flags & 2) && (t + 2 - NT) < nNT) AT_STAGE_U(nKc, nKRc, nVc, nkbeg, t + 2 - NT, s2); }
        const int k0 = kbeg + 128 * t;
        const bool active = !WIN || (k0 + 127 >= qw0 - 128 && k0 <= qw0 + 159);
        if (active) {
            if constexpr (!WIN) {
            const LAS unsigned char* Kb = lds + so + hh * 2048 + r32 * 16;
            const LAS unsigned char* vb = lds + so + KB + vlane;
            bf16x8 kf[2 * NKS];
#pragma unroll
            for (int ks = 0; ks < NKS; ++ks) { kf[2 * ks] = *(const LAS bf16x8*)(Kb + ks * 4096); kf[2 * ks + 1] = *(const LAS bf16x8*)(Kb + ks * 4096 + 512); }
            __builtin_amdgcn_sched_barrier(0);
            f32x16 s0a, s0b, s1a, s1b;
#pragma unroll
            for (int ks = 0; ks < NKS; ++ks) {
                s0a = __builtin_amdgcn_mfma_f32_32x32x16_bf16(kf[2 * ks], qf[ks], ks == 0 ? negm : s0a, 0, 0, 0);
                s0b = __builtin_amdgcn_mfma_f32_32x32x16_bf16(kf[2 * ks + 1], qf[ks], ks == 0 ? negm : s0b, 0, 0, 0);
            }
            __builtin_amdgcn_sched_barrier(0);
#pragma unroll
            for (int ks = 0; ks < NKS; ++ks) { kf[2 * ks] = *(const LAS bf16x8*)(Kb + ks * 4096 + 1024); kf[2 * ks + 1] = *(const LAS bf16x8*)(Kb + ks * 4096 + 1536); }
            s16x4 vl0[4], vh0[4], vl1[4], vh1[4];
#pragma unroll
            for (int j = 0; j < 4; ++j) { vl0[j] = vtr(vb + j * 1024); vh0[j] = vtr(vb + j * 1024 + 512); }
            __builtin_amdgcn_sched_barrier(0);
#define AT_ROWMAX(sa, sb, rm) do { rm = __builtin_fmaxf(sa[0], sb[0]); _Pragma("unroll") for (int i = 1; i < 16; ++i) rm = __builtin_fmaxf(__builtin_fmaxf(rm, sa[i]), sb[i]); rm = xhalf_max(rm); } while (0)
#define AT_RESCALE(sa, sb, rm, first) do { if ((first) || __any(rm > 8.f)) { const float dl = (first) ? rm : fmaxf(rm, 0.f); mref += dl; const float al = (first) ? 1.f : __builtin_amdgcn_exp2f(-dl); lrun *= al; \
                _Pragma("unroll") for (int i = 0; i < 16; ++i) { negm[i] = -mref; o0[i] *= al; o1[i] *= al; sa[i] -= dl; sb[i] -= dl; } asm volatile("" : "+v"(negm)); } } while (0)
#define AT_EXPPACK(sa, sb, pk) do { float ps0 = 0.f, ps1 = 0.f; _Pragma("unroll") for (int i = 0; i < 16; ++i) { sa[i] = __builtin_amdgcn_exp2f(sa[i]); sb[i] = __builtin_amdgcn_exp2f(sb[i]); ps0 += sa[i]; ps1 += sb[i]; } lrun += ps0 + ps1; \
                _Pragma("unroll") for (int j = 0; j < 4; ++j) { u32x4 w; const int b = 8 * (j & 1); \
                    if (j < 2) { w.x = cvt_pk_bf16(sa[b], sa[b + 1]); w.y = cvt_pk_bf16(sa[b + 2], sa[b + 3]); w.z = cvt_pk_bf16(sa[b + 4], sa[b + 5]); w.w = cvt_pk_bf16(sa[b + 6], sa[b + 7]); } \
                    else { w.x = cvt_pk_bf16(sb[b], sb[b + 1]); w.y = cvt_pk_bf16(sb[b + 2], sb[b + 3]); w.z = cvt_pk_bf16(sb[b + 4], sb[b + 5]); w.w = cvt_pk_bf16(sb[b + 6], sb[b + 7]); } \
                    pk[j] = __builtin_bit_cast(bf16x8, w); } } while (0)
#define AT_VF(lo, hi, j) ((bf16x8){lo[j][0], lo[j][1], lo[j][2], lo[j][3], hi[j][0], hi[j][1], hi[j][2], hi[j][3]})
            float rm0; AT_ROWMAX(s0a, s0b, rm0);
            AT_RESCALE(s0a, s0b, rm0, (t == 0));
            __builtin_amdgcn_sched_barrier(0);
            bf16x8 pk0[4];
#pragma unroll
            for (int ks = 0; ks < NKS; ++ks) {
                s1a = __builtin_amdgcn_mfma_f32_32x32x16_bf16(kf[2 * ks], qf[ks], ks == 0 ? negm : s1a, 0, 0, 0);
                s1b = __builtin_amdgcn_mfma_f32_32x32x16_bf16(kf[2 * ks + 1], qf[ks], ks == 0 ? negm : s1b, 0, 0, 0);
            }
            AT_EXPPACK(s0a, s0b, pk0);
#pragma unroll
            for (int g = 0; g < 2 * NKS; ++g) { __builtin_amdgcn_sched_group_barrier(0x008, 1, 0); __builtin_amdgcn_sched_group_barrier(0x400, 3, 0); __builtin_amdgcn_sched_group_barrier(0x002, 4, 0); }
            __builtin_amdgcn_sched_barrier(0);
#pragma unroll
            for (int j = 0; j < 4; ++j) { vl1[j] = vtr(vb + 8192 + j * 1024); vh1[j] = vtr(vb + 8192 + j * 1024 + 512); }
            __builtin_amdgcn_sched_barrier(0);
            float rm1;
#pragma unroll
            for (int j = 0; j < 4; ++j) o0 = __builtin_amdgcn_mfma_f32_32x32x16_bf16(AT_VF(vl0, vh0, j), pk0[j], o0, 0, 0, 0);
#pragma unroll
            for (int j = 0; j < 4; ++j) o1 = __builtin_amdgcn_mfma_f32_32x32x16_bf16(AT_VF(vl1, vh1, j), pk0[j], o1, 0, 0, 0);
            AT_ROWMAX(s1a, s1b, rm1);
#pragma unroll
            for (int g = 0; g < 8; ++g) { __builtin_amdgcn_sched_group_barrier(0x008, 1, 0); __builtin_amdgcn_sched_group_barrier(0x002, 3, 0); }
            __builtin_amdgcn_sched_barrier(0);
            AT_RESCALE(s1a, s1b, rm1, false);
#pragma unroll
            for (int j = 0; j < 4; ++j) { vl0[j] = vtr(vb + (4 + j) * 1024); vh0[j] = vtr(vb + (4 + j) * 1024 + 512); }
            __builtin_amdgcn_sched_barrier(0);
            bf16x8 pk1[4];
            AT_EXPPACK(s1a, s1b, pk1);
#pragma unroll
            for (int j = 0; j < 4; ++j) { vl1[j] = vtr(vb + 8192 + (4 + j) * 1024); vh1[j] = vtr(vb + 8192 + (4 + j) * 1024 + 512); }
            __builtin_amdgcn_sched_barrier(0);
#pragma unroll
            for (int j = 0; j < 4; ++j) o0 = __builtin_amdgcn_mfma_f32_32x32x16_bf16(AT_VF(vl0, vh0, j), pk1[j], o0, 0, 0, 0);
#pragma unroll
            for (int j = 0; j < 4; ++j) o1 = __builtin_amdgcn_mfma_f32_32x32x16_bf16(AT_VF(vl1, vh1, j), pk1[j], o1, 0, 0, 0);
#undef AT_ROWMAX
#undef AT_RESCALE
#undef AT_EXPPACK
#undef AT_VF
            } else {
            const LAS unsigned char* Kb = lds + so + hh * 2048 + r32 * 16;
            const LAS unsigned char* vb = lds + so + KB + vlane;
            bf16x8 kf[2 * NKS];
            bool have = false;
#pragma unroll
            for (int h = 0; h < 2; ++h) {
                if (WIN && !(k0 + 64 * h + 63 >= qw0 - 128 && k0 + 64 * h <= qw0 + 159 && k0 + 64 * h < kend)) { have = false; continue; }
                if (!have) {
#pragma unroll
                    for (int ks = 0; ks < NKS; ++ks) { kf[2 * ks] = *(const LAS bf16x8*)(Kb + ks * 4096 + h * 1024); kf[2 * ks + 1] = *(const LAS bf16x8*)(Kb + ks * 4096 + h * 1024 + 512); }
                }
                __builtin_amdgcn_sched_barrier(0);
                f32x16 sa, sb;
#pragma unroll
                for (int ks = 0; ks < NKS; ++ks) {
                    sa = __builtin_amdgcn_mfma_f32_32x32x16_bf16(kf[2 * ks], qf[ks], ks == 0 ? negm : sa, 0, 0, 0);
                    sb = __builtin_amdgcn_mfma_f32_32x32x16_bf16(kf[2 * ks + 1], qf[ks], ks == 0 ? negm : sb, 0, 0, 0);
                }
                __builtin_amdgcn_sched_barrier(0);
                s16x4 vl0[4], vh0[4], vl1[4], vh1[4];
#pragma unroll
                for (int j = 0; j < 4; ++j) { const int s16 = 4 * h + j; vl0[j] = vtr(vb + s16 * 1024); vh0[j] = vtr(vb + s16 * 1024 + 512); }
                __builtin_amdgcn_sched_barrier(0);
                if (WIN) {
                    const int kh0 = k0 + 64 * h;
                    const bool full = (kh0 >= qw0 - 97) && (kh0 + 63 <= qw0 + 128) && (kh0 + 63 < SEQ);
                    const LAS unsigned char* pb = lds + POSOFF + (kh0 - kbeg + 4 * hh) * 4;
#pragma unroll
                    for (int gq = 0; gq < 4; ++gq) {
                        const f32x4 kpa = *(const LAS f32x4*)(pb + (8 * gq) * 4), kpb = *(const LAS f32x4*)(pb + (32 + 8 * gq) * 4);
                        const int d0 = kh0 + 8 * gq + 4 * hh - qi + 128;
#pragma unroll
                        for (int e = 0; e < 4; ++e) { const int i = 4 * gq + e;
                            const float va = fmaf(-slope2, fabsf(kpa[e] - qposf), sa[i]), vb2 = fmaf(-slope2, fabsf(kpb[e] - qposf), sb[i]);
                            sa[i] = (full || (unsigned)(d0 + e) <= (unsigned)dmax) ? va : -1e30f;
                            sb[i] = (full || (unsigned)(d0 + 32 + e) <= (unsigned)dmax) ? vb2 : -1e30f; }
                    }
                }
                float rm = __builtin_fmaxf(sa[0], sb[0]);
#pragma unroll
                for (int i = 1; i < 16; ++i) rm = __builtin_fmaxf(__builtin_fmaxf(rm, sa[i]), sb[i]);
                rm = xhalf_max(rm);
                const bool first = !WIN && (t == 0) && (h == 0);
                if (first || __any(rm > 8.f)) {
                    const float dl = first ? rm : fmaxf(rm, 0.f);
                    mref += dl;
                    const float al = first ? 1.f : __builtin_amdgcn_exp2f(-dl);
                    lrun *= al;
#pragma unroll
                    for (int i = 0; i < 16; ++i) { negm[i] = -mref; o0[i] *= al; o1[i] *= al; sa[i] -= dl; sb[i] -= dl; }
                }
                float ps0 = 0.f, ps1 = 0.f;
#pragma unroll
                for (int i = 0; i < 16; ++i) { sa[i] = __builtin_amdgcn_exp2f(sa[i]); sb[i] = __builtin_amdgcn_exp2f(sb[i]); ps0 += sa[i]; ps1 += sb[i]; }
                lrun += ps0 + ps1;
                bf16x8 pk[4];
#pragma unroll
                for (int j = 0; j < 4; ++j) { u32x4 w; const int b = 8 * (j & 1);
                    if (j < 2) { w.x = cvt_pk_bf16(sa[b], sa[b + 1]); w.y = cvt_pk_bf16(sa[b + 2], sa[b + 3]); w.z = cvt_pk_bf16(sa[b + 4], sa[b + 5]); w.w = cvt_pk_bf16(sa[b + 6], sa[b + 7]); }
                    else { w.x = cvt_pk_bf16(sb[b], sb[b + 1]); w.y = cvt_pk_bf16(sb[b + 2], sb[b + 3]); w.z = cvt_pk_bf16(sb[b + 4], sb[b + 5]); w.w = cvt_pk_bf16(sb[b + 6], sb[b + 7]); }
                    pk[j] = __builtin_bit_cast(bf16x8, w); }
#pragma unroll
                for (int j = 0; j < 4; ++j) { const int s16 = 4 * h + j; vl1[j] = vtr(vb + 8192 + s16 * 1024); vh1[j] = vtr(vb + 8192 + s16 * 1024 + 512); }
                if (h == 0 && (!WIN || (k0 + 127 >= qw0 - 128 && k0 + 64 <= qw0 + 159 && k0 + 64 < kend))) {
#pragma unroll
                    for (int ks = 0; ks < NKS; ++ks) { kf[2 * ks] = *(const LAS bf16x8*)(Kb + ks * 4096 + 1024); kf[2 * ks + 1] = *(const LAS bf16x8*)(Kb + ks * 4096 + 1536); }
                    have = true;
                }
                __builtin_amdgcn_sched_barrier(0);
#pragma unroll
                for (int j = 0; j < 4; ++j) {
                    const bf16x8 v0 = (bf16x8){vl0[j][0], vl0[j][1], vl0[j][2], vl0[j][3], vh0[j][0], vh0[j][1], vh0[j][2], vh0[j][3]};
                    o0 = __builtin_amdgcn_mfma_f32_32x32x16_bf16(v0, pk[j], o0, 0, 0, 0);
                }
#pragma unroll
                for (int j = 0; j < 4; ++j) {
                    const bf16x8 v1 = (bf16x8){vl1[j][0], vl1[j][1], vl1[j][2], vl1[j][3], vh1[j][0], vh1[j][1], vh1[j][2], vh1[j][3]};
                    o1 = __builtin_amdgcn_mfma_f32_32x32x16_bf16(v1, pk[j], o1, 0, 0, 0);
                }
            }
                    }
        }
        so = so >= 2 * SB ? 0 : so + SB;
    }
    so_io = so;
    __builtin_amdgcn_s_setprio(0);
    AT_WAIT_L0(); AT_BAR();
    const float inv = 1.f / xhalf_sum(lrun);
    bf16_t* orow = Op + (size_t)qi * ldo + 8 * hh;
#pragma unroll
    for (int gp = 0; gp < 2; ++gp)
#pragma unroll
        for (int dh = 0; dh < 2; ++dh) {
            const int ga = 2 * gp, gb = 2 * gp + 1;
            unsigned ax, ay, bx2, by2;
            if (dh == 0) { ax = cvt_pk_bf16(o0[4 * ga] * inv, o0[4 * ga + 1] * inv); ay = cvt_pk_bf16(o0[4 * ga + 2] * inv, o0[4 * ga + 3] * inv); bx2 = cvt_pk_bf16(o0[4 * gb] * inv, o0[4 * gb + 1] * inv); by2 = cvt_pk_bf16(o0[4 * gb + 2] * inv, o0[4 * gb + 3] * inv); }
            else { ax = cvt_pk_bf16(o1[4 * ga] * inv, o1[4 * ga + 1] * inv); ay = cvt_pk_bf16(o1[4 * ga + 2] * inv, o1[4 * ga + 3] * inv); bx2 = cvt_pk_bf16(o1[4 * gb] * inv, o1[4 * gb + 1] * inv); by2 = cvt_pk_bf16(o1[4 * gb + 2] * inv, o1[4 * gb + 3] * inv); }
            const auto rx = __builtin_amdgcn_permlane32_swap(ax, bx2, false, false);
            const auto ry = __builtin_amdgcn_permlane32_swap(ay, by2, false, false);
            u32x4 w; w.x = rx[0]; w.y = ry[0]; w.z = rx[1]; w.w = ry[1];
            *(u32x4*)(orow + 32 * dh + 16 * gp) = w;
        }
#undef AT_STAGE_U
}


__device__ __forceinline__ void attn_win_cu(LAS unsigned char* lds, const bf16_t* __restrict__ Qp, int ldq, const bf16_t* __restrict__ Kc, const bf16_t* __restrict__ Vc, bf16_t* Op, int ldo,
                                            const float* __restrict__ posfb, int R0, int hbase, const float* __restrict__ sinkp, const int wave_s) {
    constexpr int VOFFW = 65536, POSW = 132096, NKS = 4;
    const int tid = tid_from_wave(wave_s);
    const int lane = tid & 63, r32 = lane & 31, hh = lane >> 5;
    const int wid = __builtin_amdgcn_readfirstlane(tid >> 6);
    const int kbase = R0 - 128;
    AT_WAIT_V(0);
#pragma unroll
    for (int g = 0; g < 8; ++g) { int k = kbase + 64 * g + lane; k = k < 0 ? 0 : (k >= SEQ ? SEQ - 1 : k);
        AT_DMA(Kc + ((size_t)wid * SEQ + k) * 8, lds + wid * 8192 + g * 1024); }
#pragma unroll
    for (int pce = 0; pce < 8; ++pce) { const int id = wid * 8 + pce, dh = id >> 5, blk = id & 31; int k = kbase + 16 * blk + (lane >> 2); k = k < 0 ? 0 : (k >= SEQ ? SEQ - 1 : k);
        AT_DMA(Vc + (size_t)dh * SEQ * 32 + (size_t)k * 32 + (lane & 3) * 8, lds + VOFFW + dh * 32768 + blk * 1024); }
    { int k = kbase + tid; k = k < 0 ? 0 : (k >= SEQ ? SEQ - 1 : k); *(LAS float*)(lds + POSW + tid * 4) = posfb[k]; }
    const int h = hbase + (wid >> 1);
    const float slope2 = exp2f(-0.5f * (float)(h + 1)) * LOG2E, sink2 = sinkp[h] * LOG2E;
    const int vlane = (4 * hh + ((lane & 15) >> 2)) * 64 + ((lane >> 4) & 1) * 32 + (lane & 3) * 8;
    AT_WAIT_V(0); AT_WAIT_L0(); AT_BAR();
#pragma unroll 1
    for (int i = 0; i < 4; ++i) {
        const int qw0 = R0 + 64 * i + 32 * (wid & 1), qi = qw0 + r32;
        const int dmax = (SEQ - 1 - qi + 128) < 256 ? (SEQ - 1 - qi + 128) : 256;
        bf16x8 qf[NKS];
#pragma unroll
        for (int ks = 0; ks < NKS; ++ks) qf[ks] = *(const bf16x8*)(Qp + (size_t)qi * ldq + (wid >> 1) * 64 + ks * 16 + hh * 8);
        const float qposf = *(const LAS float*)(lds + POSW + (qi - kbase) * 4);
        float mref = sink2, lrun = (hh == 0) ? 1.f : 0.f;
        f32x16 o0, o1, negm;
#pragma unroll
        for (int e = 0; e < 16; ++e) { o0[e] = 0.f; o1[e] = 0.f; negm[e] = -mref; }
        int hlo = i; if (kbase < 0 && hlo < 2) hlo = 2;
        int hhi = i + 4; { const int lim = (SEQ - 1 - kbase) >> 6; if (hhi > lim) hhi = lim; }
        bf16x8 kf[2 * NKS];
        { const LAS unsigned char* Kb0 = lds + hh * 8192 + (64 * hlo + r32) * 16;
#pragma unroll
          for (int ks = 0; ks < NKS; ++ks) { kf[2 * ks] = *(const LAS bf16x8*)(Kb0 + ks * 16384); kf[2 * ks + 1] = *(const LAS bf16x8*)(Kb0 + ks * 16384 + 512); } }
#pragma unroll 1
        for (int hf = hlo; hf <= hhi; ++hf) {
            const int kh0 = kbase + 64 * hf;
            const LAS unsigned char* Kb = lds + hh * 8192 + (64 * hf + r32) * 16;
            const LAS unsigned char* vb = lds + VOFFW + (4 * hf) * 1024 + vlane;
            s16x4 vl0[4], vh0[4], vl1[4], vh1[4];
#pragma unroll
            for (int j = 0; j < 4; ++j) { vl0[j] = vtr(vb + j * 1024); vh0[j] = vtr(vb + j * 1024 + 512); }
            __builtin_amdgcn_sched_barrier(0);
            f32x16 sa, sb;
#pragma unroll
            for (int ks = 0; ks < NKS; ++ks) {
                sa = __builtin_amdgcn_mfma_f32_32x32x16_bf16(kf[2 * ks], qf[ks], ks == 0 ? negm : sa, 0, 0, 0);
                sb = __builtin_amdgcn_mfma_f32_32x32x16_bf16(kf[2 * ks + 1], qf[ks], ks == 0 ? negm : sb, 0, 0, 0);
            }
#pragma unroll
            for (int j = 0; j < 4; ++j) { vl1[j] = vtr(vb + 32768 + j * 1024); vh1[j] = vtr(vb + 32768 + j * 1024 + 512); }
            if (hf < hhi) {
#pragma unroll
                for (int ks = 0; ks < NKS; ++ks) { kf[2 * ks] = *(const LAS bf16x8*)(Kb + 1024 + ks * 16384); kf[2 * ks + 1] = *(const LAS bf16x8*)(Kb + 1024 + ks * 16384 + 512); }
            }
            __builtin_amdgcn_sched_barrier(0);
            {
                const bool full = (kh0 >= qw0 - 97) && (kh0 + 63 <= qw0 + 128);
                const LAS unsigned char* pb = lds + POSW + (64 * hf + 4 * hh) * 4;
#pragma unroll
                for (int gq = 0; gq < 4; ++gq) {
                    const f32x4 kpa = *(const LAS f32x4*)(pb + (8 * gq) * 4), kpb = *(const LAS f32x4*)(pb + (32 + 8 * gq) * 4);
                    const int d0 = kh0 + 8 * gq + 4 * hh - qi + 128;
#pragma unroll
                    for (int e = 0; e < 4; ++e) { const int ii = 4 * gq + e;
                        const float va = fmaf(-slope2, fabsf(kpa[e] - qposf), sa[ii]), vb2 = fmaf(-slope2, fabsf(kpb[e] - qposf), sb[ii]);
                        sa[ii] = (full || (unsigned)(d0 + e) <= (unsigned)dmax) ? va : -1e30f;
                        sb[ii] = (full || (unsigned)(d0 + 32 + e) <= (unsigned)dmax) ? vb2 : -1e30f; }
                }
            }
            float rm = __builtin_fmaxf(sa[0], sb[0]);
#pragma unroll
            for (int e = 1; e < 16; ++e) rm = __builtin_fmaxf(__builtin_fmaxf(rm, sa[e]), sb[e]);
            rm = xhalf_max(rm);
            if (__any(rm > 8.f)) {
                const float dl = fmaxf(rm, 0.f); mref += dl; const float al = __builtin_amdgcn_exp2f(-dl); lrun *= al;
#pragma unroll
                for (int e = 0; e < 16; ++e) { negm[e] = -mref; o0[e] *= al; o1[e] *= al; sa[e] -= dl; sb[e] -= dl; }
                asm volatile("" : "+v"(negm));
            }
            float ps0 = 0.f, ps1 = 0.f;
#pragma unroll
            for (int e = 0; e < 16; ++e) { sa[e] = __builtin_amdgcn_exp2f(sa[e]); sb[e] = __builtin_amdgcn_exp2f(sb[e]); ps0 += sa[e]; ps1 += sb[e]; }
            lrun += ps0 + ps1;
            bf16x8 pk[4];
#pragma unroll
            for (int j = 0; j < 4; ++j) { u32x4 w; const int b = 8 * (j & 1);
                if (j < 2) { w.x = cvt_pk_bf16(sa[b], sa[b + 1]); w.y = cvt_pk_bf16(sa[b + 2], sa[b + 3]); w.z = cvt_pk_bf16(sa[b + 4], sa[b + 5]); w.w = cvt_pk_bf16(sa[b + 6], sa[b + 7]); }
                else { w.x = cvt_pk_bf16(sb[b], sb[b + 1]); w.y = cvt_pk_bf16(sb[b + 2], sb[b + 3]); w.z = cvt_pk_bf16(sb[b + 4], sb[b + 5]); w.w = cvt_pk_bf16(sb[b + 6], sb[b + 7]); }
                pk[j] = __builtin_bit_cast(bf16x8, w); }
#pragma unroll
            for (int j = 0; j < 4; ++j) {
                const bf16x8 v0 = (bf16x8){vl0[j][0], vl0[j][1], vl0[j][2], vl0[j][3], vh0[j][0], vh0[j][1], vh0[j][2], vh0[j][3]};
                o0 = __builtin_amdgcn_mfma_f32_32x32x16_bf16(v0, pk[j], o0, 0, 0, 0);
            }
#pragma unroll
            for (int j = 0; j < 4; ++j) {
                const bf16x8 v1 = (bf16x8){vl1[j][0], vl1[j][1], vl1[j][2], vl1[j][3], vh1[j][0], vh1[j][1], vh1[j][2], vh1[j][3]};
                o1 = __builtin_amdgcn_mfma_f32_32x32x16_bf16(v1, pk[j], o1, 0, 0, 0);
            }
        }
        const float inv = 1.f / xhalf_sum(lrun);
        bf16_t* orow = Op + (size_t)qi * ldo + (wid >> 1) * 64 + 8 * hh;
#pragma unroll
        for (int gp = 0; gp < 2; ++gp)
#pragma unroll
            for (int dh = 0; dh < 2; ++dh) {
                const int ga = 2 * gp, gb = 2 * gp + 1;
                unsigned ax, ay, bx2, by2;
                if (dh == 0) { ax = cvt_pk_bf16(o0[4 * ga] * inv, o0[4 * ga + 1] * inv); ay = cvt_pk_bf16(o0[4 * ga + 2] * inv, o0[4 * ga + 3] * inv); bx2 = cvt_pk_bf16(o0[4 * gb] * inv, o0[4 * gb + 1] * inv); by2 = cvt_pk_bf16(o0[4 * gb + 2] * inv, o0[4 * gb + 3] * inv); }
                else { ax = cvt_pk_bf16(o1[4 * ga] * inv, o1[4 * ga + 1] * inv); ay = cvt_pk_bf16(o1[4 * ga + 2] * inv, o1[4 * ga + 3] * inv); bx2 = cvt_pk_bf16(o1[4 * gb] * inv, o1[4 * gb + 1] * inv); by2 = cvt_pk_bf16(o1[4 * gb + 2] * inv, o1[4 * gb + 3] * inv); }
                const auto rx = __builtin_amdgcn_permlane32_swap(ax, bx2, false, false);
                const auto ry = __builtin_amdgcn_permlane32_swap(ay, by2, false, false);
                u32x4 w; w.x = rx[0]; w.y = ry[0]; w.z = rx[1]; w.w = ry[1];
                *(u32x4*)(orow + 32 * dh + 16 * gp) = w;
            }
    }
    AT_WAIT_L0(); AT_BAR();
}

__device__ __forceinline__ void tr_item64(const float* __restrict__ W, int N, int k0, int nsrc, const float* __restrict__ gs, bf16_t* WT, int ldk, int ndst, int lane) {
    const int rq = lane >> 4, kk = k0 + 16 * rq;
    f32x4 v[16];
    if (nsrc >= 0) {
#pragma unroll
        for (int i = 0; i < 16; ++i) v[i] = *(const f32x4*)(W + (size_t)(kk + i) * N + nsrc);
        if (gs) {
#pragma unroll
            for (int i4 = 0; i4 < 4; ++i4) { const f32x4 g4 = *(const f32x4*)(gs + kk + 4 * i4);
#pragma unroll
                for (int e = 0; e < 4; ++e) v[4 * i4 + e] = v[4 * i4 + e] * g4[e]; }
        }
    } else {
#pragma unroll
        for (int i = 0; i < 16; ++i) v[i] = (f32x4){0.f, 0.f, 0.f, 0.f};
    }
#pragma unroll
    for (int e = 0; e < 4; ++e) {
        u32x4 w0, w1;
        w0.x = cvt_pk_bf16(v[0][e], v[1][e]); w0.y = cvt_pk_bf16(v[2][e], v[3][e]); w0.z = cvt_pk_bf16(v[4][e], v[5][e]); w0.w = cvt_pk_bf16(v[6][e], v[7][e]);
        w1.x = cvt_pk_bf16(v[8][e], v[9][e]); w1.y = cvt_pk_bf16(v[10][e], v[11][e]); w1.z = cvt_pk_bf16(v[12][e], v[13][e]); w1.w = cvt_pk_bf16(v[14][e], v[15][e]);
        bf16_t* d = WT + (size_t)(ndst + e) * ldk + kk;
        *(u32x4*)d = w0; *(u32x4*)(d + 8) = w1;
    }
}

__device__ __constant__ double INV_FREQ[16] = {1.0, 0.5623413251903491, 0.31622776601683794, 0.1778279410038923, 0.1, 0.05623413251903491, 0.03162277660168379, 0.01778279410038923,
                                               0.01, 0.005623413251903491, 0.0031622776601683794, 0.0017782794100389228, 0.001, 0.0005623413251903491, 0.00031622776601683794, 0.00017782794100389227};
__device__ __forceinline__ void sincos_d(double x, float& sn, float& cs) {
    const double n = rint(x * 0.15915494309189535);
    double r = fma(-n, 6.283185307179586, x); r = fma(-n, 2.4492935982947064e-16, r);
    const double r2 = r * r; double s = 1.0, c = 1.0;
#pragma unroll
    for (int k = 12; k >= 1; --k) { s = 1.0 - r2 * (1.0 / (double)((2 * k) * (2 * k + 1))) * s; c = 1.0 - r2 * (1.0 / (double)((2 * k - 1) * (2 * k))) * c; }
    sn = (float)(r * s); cs = (float)c;
}


#define XB_TMO      128
#define XB_XCNT(j)  (256  + 64 * (j))
#define XB_XSUB(j)  (1280 + 64 * (j))
#define XB_XGEN(j)  (2304 + 64 * (j))
#define XB_TOP      3328
#define XB_TOPGEN   3392
#define XCD_BAR_WORDS 3456
#define XB_SPIN_CAP (1u << 18)
__device__ __forceinline__ unsigned xb_ld(unsigned* p)              { return __hip_atomic_load(p, __ATOMIC_RELAXED, __HIP_MEMORY_SCOPE_AGENT); }
__device__ __forceinline__ unsigned xb_add(unsigned* p, unsigned v) { return __hip_atomic_fetch_add(p, v, __ATOMIC_RELAXED, __HIP_MEMORY_SCOPE_AGENT); }
__device__ __forceinline__ unsigned xb_xcc_id() { return (unsigned)__builtin_amdgcn_s_getreg((3 << 11) | 20) & 0xFu; }
#define XB_SPIN(cond, bar) do { unsigned _sp = 0; while (cond) { __builtin_amdgcn_s_sleep(1); \
    if ((++_sp & 255u) == 0u) { if (xb_ld(&(bar)[XB_TMO])) break; if (_sp > XB_SPIN_CAP) { atomicAdd(&(bar)[XB_TMO], 1u); break; } } } } while (0)
struct XcdBarrier { unsigned* bar; unsigned x; volatile LAS unsigned* st; };
#define XB_T0(wave_s) ((wave_s) == 0 && __builtin_amdgcn_mbcnt_hi(~0u, __builtin_amdgcn_mbcnt_lo(~0u, 0u)) == 0u)
__device__ __forceinline__ XcdBarrier xcd_barrier_post(unsigned* bar, volatile LAS unsigned* st, const int wave_s) {
    XcdBarrier b; b.bar = bar; b.x = xb_xcc_id(); b.st = st;
    if (XB_T0(wave_s)) (void)xb_add(&bar[XB_XCNT(b.x)], 1u);
    return b;
}
__device__ __forceinline__ void xcd_barrier_complete(unsigned* bar, unsigned x, unsigned& nloc, unsigned& nx) {
    const unsigned G = gridDim.x * gridDim.y * gridDim.z;
    unsigned sum, cnt, mine, sp = 0u;
    for (;;) {
        sum = 0u; cnt = 0u; mine = 0u;
#pragma unroll
        for (unsigned j = 0; j < 16; ++j) { const unsigned c = xb_ld(&bar[XB_XCNT(j)]); sum += c; cnt += (c > 0u) ? 1u : 0u; mine = (j == x) ? c : mine; }
        if (sum == G) break;
        __builtin_amdgcn_s_sleep(1);
        if ((++sp & 255u) == 0u) { if (xb_ld(&bar[XB_TMO])) break; if (sp > XB_SPIN_CAP) { atomicAdd(&bar[XB_TMO], 1u); break; } }
    }
    nloc = mine > 0u ? mine : 1u; nx = cnt > 0u ? cnt : 1u;
}
__device__ __forceinline__ void xcd_local_barrier(const XcdBarrier& b, const int wave_s) {
    asm volatile("s_waitcnt vmcnt(0)" ::: "memory");
    __syncthreads();
    if (XB_T0(wave_s)) {
        unsigned* bar = b.bar;
        __builtin_amdgcn_s_waitcnt(0);
        const unsigned nloc = b.st[0];
        const unsigned old = xb_add(&bar[XB_XSUB(b.x)], 1u);
        const unsigned gen = old / nloc;
        if (old + 1u == (gen + 1u) * nloc) xb_add(&bar[XB_XGEN(b.x)], 1u);
        else XB_SPIN(xb_ld(&bar[XB_XGEN(b.x)]) == gen, bar);
        __builtin_amdgcn_fence(__ATOMIC_ACQUIRE, "agent");
        asm volatile("s_waitcnt vmcnt(0)" ::: "memory");
    }
    __syncthreads();
}
__device__ __forceinline__ void xcd_barrier(const XcdBarrier& b, const int wave_s) {
    asm volatile("s_waitcnt vmcnt(0)" ::: "memory");
    __syncthreads();
    if (XB_T0(wave_s)) {
        unsigned* bar = b.bar;
        __builtin_amdgcn_s_waitcnt(0);
        unsigned nloc = b.st[0], nx = b.st[1];
        if (nloc == 0u) { xcd_barrier_complete(bar, b.x, nloc, nx); b.st[0] = nloc; b.st[1] = nx; }
        const unsigned old = xb_add(&bar[XB_XSUB(b.x)], 1u);
        const unsigned gen = old / nloc;
        if (old + 1u == (gen + 1u) * nloc) {
            __builtin_amdgcn_fence(__ATOMIC_RELEASE, "agent");
            asm volatile("s_waitcnt vmcnt(0)" ::: "memory");
            const unsigned og = xb_add(&bar[XB_TOP], 1u);
            const unsigned tg = og / nx;
            if (og + 1u == (tg + 1u) * nx) xb_add(&bar[XB_TOPGEN], 1u);
            else XB_SPIN(xb_ld(&bar[XB_TOPGEN]) == tg, bar);
            __builtin_amdgcn_fence(__ATOMIC_ACQUIRE, "agent");
            xb_add(&bar[XB_XGEN(b.x)], 1u);
            asm volatile("s_waitcnt vmcnt(0)" ::: "memory");
        } else {
            XB_SPIN(xb_ld(&bar[XB_XGEN(b.x)]) == gen, bar);
            __builtin_amdgcn_fence(__ATOMIC_ACQUIRE, "agent");
            asm volatile("s_waitcnt vmcnt(0)" ::: "memory");
        }
    }
    __syncthreads();
}


__device__ __forceinline__ unsigned char* opq(unsigned char* p) { asm volatile("" : "+s"(p)); return p; }
#define P_HB(w) ((bf16_t*)((w) + WS_HB))
#define P_R0(w) ((bf16_t*)((w) + WS_R0))
#define P_KVM(w) ((bf16_t*)((w) + WS_KVM))
#define P_OB(w) ((bf16_t*)((w) + WS_O))
#define P_KR(w) ((bf16_t*)((w) + WS_KR))
#define P_LAT(w) ((bf16_t*)((w) + WS_LAT))
#define P_SSQH(w) ((float*)((w) + WS_SSQH))
#define P_SSQL(w) ((float*)((w) + WS_SSQL))
#define P_COS(w) ((float*)((w) + WS_COS))
#define P_SIN(w) ((float*)((w) + WS_SIN))
#define P_POSF(w) ((float*)((w) + WS_POSF))


#define CONVERT_LAYER(LY, PARTS, wk, nwk, lane_) do { \
    const int ly_ = (LY), j_ = ly_ >> 1, cg4_ = 4 * ((lane_) & 15); \
    constexpr int I0 = 384, I1 = 256, I2 = 192, I3 = 144, I4 = 128, I6 = 1408, I7 = 704; \
    const int nmix_ = (ly_ & 1) ? (I2 + I3 + I4 + I1) : (I0 + I1); \
    const int lo_ = ((PARTS) & 1) ? 0 : nmix_, hi_ = ((PARTS) & 2) ? nmix_ + I6 + I7 : nmix_; \
    for (int it_ = lo_ + (wk); it_ < hi_; it_ += (nwk)) { \
        int r = it_; \
        if (r >= nmix_) { r -= nmix_; \
            if (r < I6) { const int kb = r / 88, nd = (r % 88) * 64 + cg4_; const int ns = ((nd >> 7) & 1) * DFF + (nd >> 8) * 128 + (nd & 127); \
                tr_item64(ffn_w_gu + (size_t)ly_ * DM * GU, GU, kb * 64, ns, norm_ffn + ly_ * DM, (bf16_t*)(ws + WS_WGU + ly_ * SZ_WGU), DM, nd, (lane_)); } \
            else { r -= I6; const int kb = r / 16, nd = (r % 16) * 64 + cg4_; \
                tr_item64(ffn_w_down + (size_t)ly_ * DFF * DM, DM, kb * 64, nd, nullptr, (bf16_t*)(ws + WS_WDN + ly_ * SZ_WDN), DFF, nd, (lane_)); } \
        } else if ((ly_ & 1) == 0) { \
            if (r < I0) { const int kb = r / 24, nd = (r % 24) * 64 + cg4_; \
                tr_item64(a_w_qkv + (size_t)j_ * DM * AQKV, AQKV, kb * 64, nd, norm_mix + ly_ * DM, (bf16_t*)(ws + WS_WQKV + j_ * SZ_WQKV), DM, nd, (lane_)); } \
            else { r -= I0; const int kb = r / 16, nd = (r % 16) * 64 + cg4_; \
                tr_item64(a_w_o + (size_t)j_ * DM * DM, DM, kb * 64, nd, nullptr, (bf16_t*)(ws + WS_WOA + j_ * SZ_WO), DM, nd, (lane_)); } \
        } else { \
            if (r < I2) { const int kb = r / 12, nd = (r % 12) * 64 + cg4_; const int ns = nd < 256 ? 384 + nd : (nd < 640 ? nd - 256 : (nd < 672 ? nd : -1)); \
                tr_item64(b_w_in + (size_t)j_ * DM * BIN, BIN, kb * 64, ns, norm_mix + ly_ * DM, (bf16_t*)(ws + WS_WIN + j_ * SZ_WIN), DM, nd, (lane_)); } \
            else if (r < I2 + I3) { r -= I2; const int kb = r / 24, nd = (r % 24) * 64 + cg4_; \
                tr_item64(b_w_uq + (size_t)j_ * QL * UQ, UQ, kb * 64, nd, b_g_q + j_ * QL, (bf16_t*)(ws + WS_WUQ + j_ * SZ_WUQ), QL, nd, (lane_)); } \
            else if (r < I2 + I3 + I4) { r -= I2 + I3; const int kb = r / 32, nd = (r % 32) * 64 + cg4_; \
                tr_item64(b_w_ukv + (size_t)j_ * KVL * UKV, UKV, kb * 64, nd, b_g_kv + j_ * KVL, (bf16_t*)(ws + WS_WUKV + j_ * SZ_WUKV), KVL, nd, (lane_)); } \
            else { r -= I2 + I3 + I4; const int kb = r / 16, nd = (r % 16) * 64 + cg4_; \
                tr_item64(b_w_o + (size_t)j_ * DM * DM, DM, kb * 64, nd, nullptr, (bf16_t*)(ws + WS_WOB + j_ * SZ_WO), DM, nd, (lane_)); } \
        } \
    } } while (0)

struct Params { const float* in[16]; float* out; unsigned char* ws; };

__global__ void __launch_bounds__(512, 2) mk_fwd(Params P) {
    extern __shared__ __attribute__((aligned(16))) unsigned char lds_raw[];
    LAS unsigned char* lds = (LAS unsigned char*)lds_raw;
    cg::grid_group grid = cg::this_grid();
    const int wave_s = __builtin_amdgcn_readfirstlane((int)threadIdx.x >> 6);
    const int G = gridDim.x, bx = blockIdx.x;
    const int vcu = (G % 8 == 0) ? (bx % 8) * (G / 8) + bx / 8 : bx;
    unsigned char* ws = P.ws;
    const float* x = P.in[0]; const int* positions = (const int*)P.in[1];
    const float *norm_mix = P.in[2], *norm_ffn = P.in[3], *a_w_qkv = P.in[4], *a_sink = P.in[5], *a_w_o = P.in[6], *b_w_in = P.in[7], *b_g_q = P.in[8], *b_g_kv = P.in[9],
                *b_w_uq = P.in[10], *b_w_ukv = P.in[11], *b_w_o = P.in[12], *ffn_w_gu = P.in[13], *ffn_w_down = P.in[14], *final_norm = P.in[15];
    float* out = P.out;
    unsigned* barw = (unsigned*)ws;
    volatile LAS unsigned* xst = (volatile LAS unsigned*)(lds + 131072 + 512);
    { const int t0 = tid_from_wave(wave_s); if (t0 < 4) xst[t0] = 0u; }
    __syncthreads();
    bf16_t* hb = (bf16_t*)(ws + WS_HB); bf16_t* r0 = (bf16_t*)(ws + WS_R0); bf16_t* kvm = (bf16_t*)(ws + WS_KVM); bf16_t* ob = (bf16_t*)(ws + WS_O); bf16_t* latb = (bf16_t*)(ws + WS_O);
    bf16_t* krb = (bf16_t*)(ws + WS_KR); float* ssqh = (float*)(ws + WS_SSQH); float* ssql = (float*)(ws + WS_SSQL); float* cosT = (float*)(ws + WS_COS); float* sinT = (float*)(ws + WS_SIN); float* posf = (float*)(ws + WS_POSF);

    XcdBarrier xbar; xbar.bar = barw; xbar.st = xst; xbar.x = xb_xcc_id();
    if (XB_T0(wave_s)) {
        const unsigned rk = xb_add(&barw[XB_XCNT(xbar.x)], 1u);
        unsigned nloc, nx; xcd_barrier_complete(barw, xbar.x, nloc, nx);
        unsigned ok = (G % 8 == 0 && xbar.x < 8u) ? 1u : 0u;
#pragma unroll
        for (unsigned jx = 0; jx < 8; ++jx) if (xb_ld(&barw[XB_XCNT(jx)]) != (unsigned)(G / 8)) ok = 0u;
        xst[0] = nloc; xst[1] = nx; xst[2] = rk; xst[3] = ok;
    }
    __syncthreads();
    const int lmode = __builtin_amdgcn_readfirstlane((int)xst[3]);
    const int xrank = __builtin_amdgcn_readfirstlane((int)xst[2]);
    const int cid = lmode ? xrank * 8 + (int)xbar.x : bx;
    const int cidr = lmode ? (G / 8 - 1 - xrank) * 8 + (int)xbar.x : G - 1 - bx;
    const int vcu2 = lmode ? (int)xbar.x * (G / 8) + xrank : vcu;
    for (int rep = 0; rep < REP_PRO; ++rep) {
        const int tid = tid_from_wave(wave_s);
        const int lane = tid & 63, wave = __builtin_amdgcn_readfirstlane(tid >> 6);
        const int gw = vcu * 8 + wave, NGW = G * 8;
        CONVERT_LAYER(0, 1, gw, NGW, lane);
        for (int m = gw; m < T; m += NGW) {
            const f32x4* xr = (const f32x4*)(x + (size_t)m * DM) + lane; f32x4 v[4]; float s = 0.f;
#pragma unroll
            for (int j = 0; j < 4; ++j) { v[j] = xr[64 * j]; s += dot4(v[j]); }
            s = wave_sum(s);
            u32x2* o8 = (u32x2*)(hb + (size_t)m * DM) + lane;
#pragma unroll
            for (int j = 0; j < 4; ++j) { u32x2 w; w.x = cvt_pk_bf16(v[j][0], v[j][1]); w.y = cvt_pk_bf16(v[j][2], v[j][3]); o8[64 * j] = w; }
            if (lane < 16) ssqh[(size_t)m * 16 + lane] = (lane == 0) ? s : 0.f;
        }
        for (int idx = (vcu * 512 + tid); idx < T * 16; idx += G * 512) { const int t = idx >> 4, i = idx & 15; float sn, cs; sincos_d((double)positions[t] * INV_FREQ[i], sn, cs); cosT[idx] = cs; sinT[idx] = sn; if (i == 0) posf[t] = (float)positions[t]; }
    }
    if (gridDim.y > 1u) grid.sync();
    GSYNC();

#pragma unroll 1
    for (int layer = 0; layer < 4; ++layer) {
        const int j = layer >> 1;
        if ((layer & 1) == 0) {
            { unsigned char* wsl = opq(ws); pg8::Gemm g{P_HB(wsl), (const bf16_t*)(wsl + WS_WQKV + j * SZ_WQKV), T, AQKV, DM, DM}; pg8::StaticOrder S; S.init(T, AQKV, G, cid);
              EpiQkvA E{P_R0(wsl), P_KVM(wsl), P_KVM(wsl) + (size_t)T * 256, (RowScale{P_SSQH(wsl), 16, 0, 4, 1.f / 1024.f}), 0.125f * LOG2E};
              pg8::gemm_phase<EpiQkvA, pg8::StaticOrder, true>(lds, g, S, E, wave_s); }
            if (layer == 0) {
                const int busy = ((T / 256) * (AQKV / 256)) % G;
                const int tid = tid_from_wave(wave_s); const int lane = tid & 63, wave = __builtin_amdgcn_readfirstlane(tid >> 6);
                if (busy == 0) CONVERT_LAYER(0, 2, cid * 8 + wave, G * 8, lane);
                else if (cid >= busy) CONVERT_LAYER(0, 2, (cid - busy) * 8 + wave, (G - busy) * 8, lane);
            }
            GSYNC_L();
            if (G == 256) { unsigned char* wsl = opq(ws);
              const int b = vcu2 >> 5, kvh = (vcu2 >> 3) & 3, R0 = (vcu2 & 7) * 256; const size_t rb = (size_t)b * SEQ;
              attn_win_cu(lds, P_R0(wsl) + rb * AQKV + kvh * 256, AQKV, P_KVM(wsl) + (size_t)(b * 4 + kvh) * 8 * SEQ * 8, P_KVM(wsl) + (size_t)T * 256 + (size_t)(b * 4 + kvh) * 2 * SEQ * 32,
                          P_OB(wsl) + rb * DM + kvh * 256, DM, P_POSF(wsl) + rb, R0, kvh * 4, a_sink + j * 16, wave_s);
            } else
            for (int rep = 0; rep < REP_ATT; ++rep) { unsigned char* wsl = opq(ws); const int nper = (1024 + G - 1) / G;
              const int u0 = vcu2 * nper, u1 = ((vcu2 + 1) * nper < 1024) ? (vcu2 + 1) * nper : 1024; int ring = 0;
              for (int ui = u0; ui < u1; ++ui) {
                  const int b = ui >> 7, kvh = (ui >> 5) & 3, qb = ui & 31;
                  const int un = ui + 1, nb = un >> 7, nkvh = (un >> 5) & 3, nqb = un & 31;
                  const size_t rb = (size_t)b * SEQ;
                  attn_unit2<64, true>(lds, P_R0(wsl) + rb * AQKV + kvh * 256, AQKV, P_KVM(wsl) + (size_t)(b * 4 + kvh) * 8 * SEQ * 8, nullptr, P_KVM(wsl) + (size_t)T * 256 + (size_t)(b * 4 + kvh) * 2 * SEQ * 32,
                                      P_OB(wsl) + rb * DM + kvh * 256, DM, P_POSF(wsl) + rb, qb * 64, kvh * 4, a_sink + j * 16, wave_s,
                                      P_KVM(wsl) + (size_t)(nb * 4 + nkvh) * 8 * SEQ * 8, nullptr, P_KVM(wsl) + (size_t)T * 256 + (size_t)(nb * 4 + nkvh) * 2 * SEQ * 32, nqb * 64,
                                      (ui > u0 ? 1 : 0) | (un < u1 ? 2 : 0), ring);
              } }
            GSYNC_L();
        } else {
            { unsigned char* wsl = opq(ws); pg8::Gemm g{P_HB(wsl), (const bf16_t*)(wsl + WS_WIN + j * SZ_WIN), T, BINP, DM, DM}; pg8::StaticOrder S; S.init(T, BINP, G, cid);
              EpiLat E{P_LAT(wsl), P_SSQL(wsl), P_KR(wsl), P_COS(wsl), P_SIN(wsl), (RowScale{P_SSQH(wsl), 16, 0, 4, 1.f / 1024.f})};
              pg8::gemm_phase<EpiLat, pg8::StaticOrder, true>(lds, g, S, E, wave_s); }
            GSYNC_L();
            { unsigned char* wsl = opq(ws); pg8::Gemm g{P_LAT(wsl) + 256, (const bf16_t*)(wsl + WS_WUQ + j * SZ_WUQ), T, UQ, QL, BINP}; pg8::StaticOrder S; S.init(T, UQ, G, cid);
              EpiUq E{P_R0(wsl), P_COS(wsl), P_SIN(wsl), RowScale{P_SSQL(wsl), 24, 8, 3, 1.f / 384.f}, 0.10206207261596575f * LOG2E};
              pg8::gemm_phase<EpiUq, pg8::StaticOrder, true>(lds, g, S, E, wave_s); }
            { unsigned char* wsl = opq(ws); pg8::Gemm g{P_LAT(wsl), (const bf16_t*)(wsl + WS_WUKV + j * SZ_WUKV), T, UKV, KVL, BINP}; pg8::StaticOrder S; S.init(T, UKV, G, cidr);
              EpiKvB E{P_KVM(wsl), P_KVM(wsl) + (size_t)T * 1024, RowScale{P_SSQL(wsl), 24, 0, 2, 1.f / 256.f}};
              pg8::gemm_phase<EpiKvB, pg8::StaticOrder, true>(lds, g, S, E, wave_s); }
            GSYNC_L();
            for (int rep = 0; rep < REP_ATT; ++rep) { unsigned char* wsl = opq(ws); const int nper = (1024 + G - 1) / G;
              const int u0 = vcu2 * nper, u1 = ((vcu2 + 1) * nper < 1024) ? (vcu2 + 1) * nper : 1024; int ring = 0;
              for (int ui = u0; ui < u1; ++ui) {
                  int bh = ui >> 3, qb = ui & 7, nbh = (ui + 1) >> 3;
                  if (G == 256) { const int stepi = ui - u0; bh = (vcu2 >> 5) * 16 + ((vcu2 & 31) >> 3) + 4 * stepi; qb = vcu2 & 7; nbh = bh + 4; }
                  const int b = bh >> 4, h = bh & 15;
                  const int un = ui + 1, nb = nbh >> 4, nh = nbh & 15;
                  const size_t rb = (size_t)b * SEQ;
                  attn_unit2<96, false>(lds, P_R0(wsl) + rb * UQ + h * 96, UQ, P_KVM(wsl) + (size_t)(b * 16 + h) * 8 * SEQ * 8, P_KR(wsl) + (size_t)b * 4 * SEQ * 8, P_KVM(wsl) + (size_t)T * 1024 + (size_t)(b * 16 + h) * 2 * SEQ * 32,
                                       P_OB(wsl) + rb * DM + h * 64, DM, P_POSF(wsl) + rb, qb * 256, 0, nullptr, wave_s,
                                       P_KVM(wsl) + (size_t)(nb * 16 + nh) * 8 * SEQ * 8, P_KR(wsl) + (size_t)nb * 4 * SEQ * 8, P_KVM(wsl) + (size_t)T * 1024 + (size_t)(nb * 16 + nh) * 2 * SEQ * 32, (un & 7) * 256,
                                       (ui > u0 ? 1 : 0) | (un < u1 ? 2 : 0), ring);
              } }
            GSYNC_L();
        }
        { unsigned char* wsl = opq(ws); const bf16_t* wo = (layer & 1) ? (const bf16_t*)(wsl + WS_WOB + j * SZ_WO) : (const bf16_t*)(wsl + WS_WOA + j * SZ_WO);
          pg8::Gemm g{P_OB(wsl), wo, T, DM, DM, DM}; pg8::StaticOrder S; S.init(T, DM, G, cid);
          EpiResid E{P_HB(wsl), P_SSQH(wsl)};
          pg8::gemm_phase<EpiResid, pg8::StaticOrder, true>(lds, g, S, E, wave_s); }
        GSYNC();
        { unsigned char* wsl = opq(ws); pg8::Gemm g{P_HB(wsl), (const bf16_t*)(wsl + WS_WGU + layer * SZ_WGU), T, GU, DM, DM}; pg8::StaticOrder S; S.init(T, GU, G, cid);
          EpiSwiglu E{P_R0(wsl), (RowScale{P_SSQH(wsl), 16, 0, 4, 1.f / 1024.f})};
          pg8::gemm_phase<EpiSwiglu, pg8::StaticOrder, true>(lds, g, S, E, wave_s); }
        if (layer < 3) {
            const int busy = ((T / 256) * (GU / 256)) % G;
            const int tid = tid_from_wave(wave_s); const int lane = tid & 63, wave = __builtin_amdgcn_readfirstlane(tid >> 6);
            if (busy == 0) CONVERT_LAYER(layer + 1, 3, cid * 8 + wave, G * 8, lane);
            else if (cid >= busy) CONVERT_LAYER(layer + 1, 3, (cid - busy) * 8 + wave, (G - busy) * 8, lane);
        }
        GSYNC_L();
        { unsigned char* wsl = opq(ws); pg8::Gemm g{P_R0(wsl), (const bf16_t*)(wsl + WS_WDN + layer * SZ_WDN), T, DM, DFF, DFF}; pg8::StaticOrder S; S.init(T, DM, G, cid);
          EpiResid E{P_HB(wsl), P_SSQH(wsl)};
          pg8::gemm_phase<EpiResid, pg8::StaticOrder, true>(lds, g, S, E, wave_s); }
        GSYNC();
    }
    {
        const int tid = tid_from_wave(wave_s);
        const int lane = tid & 63, wave = __builtin_amdgcn_readfirstlane(tid >> 6);
        const int gw = vcu * 8 + wave, NGW = G * 8;
        for (int m = gw; m < T; m += NGW) {
            float s = (lane < 16) ? ssqh[(size_t)m * 16 + lane] : 0.f; s = wave_sum(s);
            const float rstd = rsqrtf(s * (1.f / 1024.f) + EPSN);
            const u32x2* hr = (const u32x2*)(hb + (size_t)m * DM) + lane; f32x4* xr = (f32x4*)(out + (size_t)m * DM) + lane; const f32x4* gr = (const f32x4*)final_norm + lane;
#pragma unroll
            for (int jj = 0; jj < 4; ++jj) { const u32x2 w = hr[64 * jj]; f32x4 v; v[0] = __uint_as_float(w.x << 16); v[1] = __uint_as_float(w.x & 0xffff0000u); v[2] = __uint_as_float(w.y << 16); v[3] = __uint_as_float(w.y & 0xffff0000u);
                xr[64 * jj] = v * rstd * gr[64 * jj]; }
        }
    }
}

extern "C" void kernel_launch(void* const* d_in, const int* in_sizes, int n_in, void* d_out, int out_size, void* d_ws, size_t ws_size, hipStream_t stream) {
    static int grid = 0;
    if (grid == 0) {
        if (n_in != 16 || out_size != T * DM || ws_size < WS_END) { fprintf(stderr, "kernel_launch: unexpected shapes (n_in %d out %d ws %zu need %zu)\n", n_in, out_size, ws_size, (size_t)WS_END); grid = -1; return; }
        int dev = 0, cus = 0, per_cu = 0;
        hipGetDevice(&dev); hipDeviceGetAttribute(&cus, hipDeviceAttributeMultiprocessorCount, dev);
        if (hipFuncSetAttribute((const void*)mk_fwd, hipFuncAttributeMaxDynamicSharedMemorySize, LDS_BYTES) != hipSuccess) { fprintf(stderr, "kernel_launch: hipFuncSetAttribute failed\n"); grid = -1; return; }
        if (hipOccupancyMaxActiveBlocksPerMultiprocessor(&per_cu, (const void*)mk_fwd, 512, LDS_BYTES) != hipSuccess || per_cu < 1) { fprintf(stderr, "kernel_launch: occupancy query says %d\n", per_cu); per_cu = 1; }
        (void)hipGetLastError();
        grid = cus;
    }
    if (grid < 0) return;
    if (hipMemsetAsync(d_ws, 0, 16384, stream) != hipSuccess) { fprintf(stderr, "kernel_launch: hipMemsetAsync of the barrier words failed\n"); return; }
    Params p{};
    for (int i = 0; i < 16; ++i) p.in[i] = (const float*)d_in[i];
    p.out = (float*)d_out; p.ws = (unsigned char*)d_ws;
    void* args[] = {&p};
    hipError_t e = hipLaunchCooperativeKernel((const void*)mk_fwd, dim3(grid), dim3(512), args, LDS_BYTES, stream);
    if (e != hipSuccess) fprintf(stderr, "cooperative launch failed: %s (grid %d)\n", hipGetErrorString(e), grid);
}
```
